# Optimizing an MI355X kernel written in HIP

```python
import jax, jax.numpy as jnp
from jax import lax
import numpy as np

D_MODEL = 2048
BATCH = 4
SEQ = 2048
DEPTH = 4

MEM_LEN = 256
D_FF = 5632
CONV_WIDTH = 1024
CONV_K = 3
HGRN_HEADS = 8
HGRN_DK = 128
HGRN_DV = 128
HGRN_KW = HGRN_HEADS * HGRN_DK
HGRN_VW = HGRN_HEADS * HGRN_DV
HGRN_CHUNK = 64
XATTN_HEADS = 4
XATTN_DH = 256
XATTN_WIDTH = XATTN_HEADS * XATTN_DH
N_BRANCH = 3
BRANCH_WIDTH = 1024
EPS = 1e-6
F_FLOOR = 1e-30
IN_WIDTHS = (CONV_WIDTH, CONV_WIDTH, CONV_WIDTH,
             HGRN_KW, HGRN_KW, HGRN_VW, HGRN_VW,
             XATTN_WIDTH,
             N_BRANCH * D_MODEL)
IN_COLS = sum(IN_WIDTHS)
IN_SPLITS = tuple(int(v) for v in np.cumsum(IN_WIDTHS)[:-1])

kernel_name = "hybrid_gated_conv_hgrn2_memxattn_macaron"


def rmsnorm(x, g):
    xf = x.astype(jnp.float32)
    y = xf * lax.rsqrt(jnp.mean(xf * xf, axis=-1, keepdims=True) + EPS) * g.astype(jnp.float32)
    return y.astype(x.dtype)


def swiglu(h, w_gate, w_up, w_down):
    return (jax.nn.silu(h @ w_gate) * (h @ w_up)) @ w_down


def short_gated_conv(x_in, b_gate, c_gate, conv_w):
    u = c_gate * x_in
    seq = u.shape[1]
    u_pad = jnp.pad(u, ((0, 0), (CONV_K - 1, 0), (0, 0)))
    y = sum(conv_w[j] * u_pad[:, j:j + seq] for j in range(CONV_K))
    return b_gate * y


def hgrn2_chunked(q, k, v, log_f):
    bsz, seq = q.shape[0], q.shape[1]
    n_chunks = seq // HGRN_CHUNK

    def to_chunks(t):
        return t.reshape(bsz, n_chunks, HGRN_CHUNK, HGRN_HEADS, -1).transpose(1, 0, 3, 2, 4)

    causal = jnp.tril(jnp.ones((HGRN_CHUNK, HGRN_CHUNK), dtype=bool))[:, :, None]

    def step(state, inp):
        qc, kc, vc, lfc = inp
        b = jnp.cumsum(lfc, axis=2)
        diff = b[:, :, :, None, :] - b[:, :, None, :, :]
        decay = jnp.where(causal, jnp.exp(jnp.where(causal, diff, 0.0)), 0.0)
        scores = jnp.einsum('bhtd,bhsd,bhtsd->bhts', qc, kc, decay)
        o = (jnp.einsum('bhts,bhsv->bhtv', scores, vc)
             + jnp.einsum('bhtd,bhdv->bhtv', qc * jnp.exp(b), state))
        b_last = b[:, :, -1, :]
        state = (jnp.exp(b_last)[..., None] * state
                 + jnp.einsum('bhsd,bhsv->bhdv', kc * jnp.exp(b_last[:, :, None, :] - b), vc))
        return state, o

    s0 = jnp.zeros((bsz, HGRN_HEADS, HGRN_DK, HGRN_DV), jnp.float32)
    _, o = lax.scan(step, s0, (to_chunks(q), to_chunks(k), to_chunks(v), to_chunks(log_f)))
    return o.transpose(1, 0, 3, 2, 4).reshape(bsz, seq, HGRN_HEADS, HGRN_DV)


def hgrn2_branch(q, z, i, g, lb, norm_g):
    bsz, seq = q.shape[0], q.shape[1]
    shp_k = (bsz, seq, HGRN_HEADS, HGRN_DK)
    qf = q.astype(jnp.float32).reshape(shp_k)
    zf = z.astype(jnp.float32).reshape(shp_k)
    vf = i.astype(jnp.float32).reshape(bsz, seq, HGRN_HEADS, HGRN_DV)
    lbh = lb.astype(jnp.float32).reshape(HGRN_HEADS, HGRN_DK)
    f = lbh + (1.0 - lbh) * jax.nn.sigmoid(zf)
    log_f = jnp.log(jnp.maximum(f, F_FLOOR))
    kf = (1.0 - lbh) * jax.nn.sigmoid(-zf)
    o = hgrn2_chunked(qf, kf, vf, log_f)
    o = rmsnorm(o, norm_g).reshape(bsz, seq, HGRN_VW)
    return o.astype(g.dtype) * jax.nn.silu(g)


def memory_cross_attention(q, mem_n, w_mem_kv):
    bsz, seq = q.shape[0], q.shape[1]
    kv = mem_n @ w_mem_kv
    k, v = jnp.split(kv, 2, axis=-1)
    qh = q.reshape(bsz, seq, XATTN_HEADS, XATTN_DH)
    kh = k.reshape(bsz, -1, XATTN_HEADS, XATTN_DH)
    vh = v.reshape(bsz, -1, XATTN_HEADS, XATTN_DH)
    scores = jnp.einsum('bshd,bmhd->bhsm', qh, kh).astype(jnp.float32) * (XATTN_DH ** -0.5)
    probs = jax.nn.softmax(scores, axis=-1).astype(vh.dtype)
    out = jnp.einsum('bhsm,bmhd->bshd', probs, vh)
    return out.reshape(bsz, seq, XATTN_WIDTH)


def setup_inputs(seed: int = 0) -> dict:
    key = jax.random.key(seed)
    ks = jax.random.split(key, 24)

    def nrm(k, shape, scale):
        return jax.random.normal(k, shape, jnp.float32) * scale

    def gain(k, shape):
        return 1.0 + 0.02 * jax.random.normal(k, shape, jnp.float32)

    L, D, F = DEPTH, D_MODEL, D_FF
    return {
        "x": nrm(ks[0], (BATCH, SEQ, D), 1.0),
        "mem": nrm(ks[1], (BATCH, MEM_LEN, D), 1.0),
        "norm_ffn1": gain(ks[2], (L, D)),
        "ffn1_w_gate": nrm(ks[3], (L, D, F), D ** -0.5),
        "ffn1_w_up": nrm(ks[4], (L, D, F), D ** -0.5),
        "ffn1_w_down": nrm(ks[5], (L, F, D), F ** -0.5),
        "norm_mix": gain(ks[6], (L, D)),
        "w_in": nrm(ks[7], (L, D, IN_COLS), D ** -0.5),
        "conv_w": nrm(ks[8], (L, CONV_K, CONV_WIDTH), CONV_K ** -0.5),
        "hgrn_lb_logits": nrm(ks[9], (L, HGRN_KW), 0.1),
        "hgrn_norm": gain(ks[10], (L, HGRN_DV)),
        "mem_norm": gain(ks[11], (L, D)),
        "w_mem_kv": nrm(ks[12], (L, D, 2 * XATTN_WIDTH), D ** -0.5),
        "w_branch": nrm(ks[13], (L, N_BRANCH, BRANCH_WIDTH, D), BRANCH_WIDTH ** -0.5),
        "w_o": nrm(ks[14], (L, D, D), D ** -0.5),
        "norm_ffn2": gain(ks[15], (L, D)),
        "ffn2_w_gate": nrm(ks[16], (L, D, F), D ** -0.5),
        "ffn2_w_up": nrm(ks[17], (L, D, F), D ** -0.5),
        "ffn2_w_down": nrm(ks[18], (L, F, D), F ** -0.5),
        "final_norm": gain(ks[19], (D,)),
    }


def reference(x, mem, norm_ffn1, ffn1_w_gate, ffn1_w_up, ffn1_w_down, norm_mix, w_in, conv_w,
              hgrn_lb_logits, hgrn_norm, mem_norm, w_mem_kv, w_branch, w_o, norm_ffn2,
              ffn2_w_gate, ffn2_w_up, ffn2_w_down, final_norm):
    bsz, seq = x.shape[0], x.shape[1]
    p = jax.nn.softmax(hgrn_lb_logits.astype(jnp.float32), axis=0)
    lower_bounds = jnp.cumsum(p, axis=0) - p[0]

    for l in range(DEPTH):
        x = x + 0.5 * swiglu(rmsnorm(x, norm_ffn1[l]), ffn1_w_gate[l], ffn1_w_up[l], ffn1_w_down[l])

        h = rmsnorm(x, norm_mix[l])
        (c_x, c_b, c_c, h_q, h_f, h_i, h_g, a_q, gate_logits) = jnp.split(h @ w_in[l], IN_SPLITS, axis=-1)
        y_conv = short_gated_conv(c_x, c_b, c_c, conv_w[l])
        y_hgrn = hgrn2_branch(h_q, h_f, h_i, h_g, lower_bounds[l], hgrn_norm[l])
        y_mem = memory_cross_attention(a_q, rmsnorm(mem, mem_norm[l]), w_mem_kv[l])

        ys = jnp.stack([y_conv, y_hgrn, y_mem], axis=2)
        proj = jnp.einsum('bsnc,ncd->bsnd', ys, w_branch[l])
        gates = jax.nn.sigmoid(gate_logits.reshape(bsz, seq, N_BRANCH, D_MODEL))
        merged = jnp.sum(gates * proj, axis=2)
        x = x + merged @ w_o[l]

        x = x + 0.5 * swiglu(rmsnorm(x, norm_ffn2[l]), ffn2_w_gate[l], ffn2_w_up[l], ffn2_w_down[l])

    return rmsnorm(x, final_norm)
```

```cpp
#include <hip/hip_runtime.h>
#include <cstdio>
#include <cstdint>

#ifndef MK_PER_PHASE
#define MK_PER_PHASE 0
#endif
#ifndef LAZY_D2
#define LAZY_D2 1
#endif

#define LAS __attribute__((address_space(3)))
#define GAS __attribute__((address_space(1)))
typedef unsigned short bf16;
typedef short bf16x8 __attribute__((ext_vector_type(8)));
typedef float f32x4 __attribute__((ext_vector_type(4)));
typedef float f32x2 __attribute__((ext_vector_type(2)));
typedef unsigned u32x4 __attribute__((ext_vector_type(4)));
typedef unsigned u32x2 __attribute__((ext_vector_type(2)));

constexpr int D = 2048, BATCH = 4, SEQ = 2048, DEPTH = 4, M = BATCH * SEQ, MEML = 256, MEMR = BATCH * MEML;
constexpr int FF = 5632, INC = 14336, NBW = 1024, PST = 8192;
constexpr int C_CX = 0, C_CB = 2048, C_HQ = 3072, C_HF = 4096, C_HI = 5120, C_HG = 6144, C_AQ = 7168, C_GATE = 8192;
constexpr float EPS = 1e-6f;
constexpr int NUNIT_H = BATCH * 8 * 32;

constexpr size_t MiB = 1u << 20;
constexpr size_t WS_CTL = 0, CTL_ZERO_BYTES = 16384;
constexpr size_t CTL_BAR_OFF = 0, CTL_PANEL_OFF = 14080;
constexpr size_t WS_LBV = 2 * MiB;
constexpr size_t WS_WL = 3 * MiB;
constexpr size_t WL_GU1 = 0, WL_D1 = 44 * MiB, WL_IN = 66 * MiB, WL_BR = 122 * MiB, WL_O = 134 * MiB, WL_GU2 = 142 * MiB, WL_D2 = 186 * MiB, WL_SIZE = 208 * MiB;
constexpr size_t WS_WK = WS_WL + 4 * WL_SIZE;
constexpr size_t WS_WV = WS_WK + 16 * MiB;
constexpr size_t WS_MEMB = WS_WV + 16 * MiB;
constexpr size_t WS_MEMBP = WS_MEMB + 4 * MiB;
constexpr size_t WS_KB = WS_MEMBP + 4 * MiB;
constexpr size_t WS_VT = WS_KB + 8 * MiB;
constexpr size_t WS_XB = WS_VT + 8 * MiB;
constexpr size_t WS_P = WS_XB + 32 * MiB;
constexpr size_t WS_GF = WS_P + 128 * MiB;
constexpr size_t WS_YCAT = WS_GF + 96 * MiB;
constexpr size_t WS_SCR = WS_YCAT + 48 * MiB;
constexpr size_t WS_HMID = WS_SCR;
constexpr size_t WS_UT = WS_SCR;
constexpr size_t WS_ST = WS_UT + 32 * MiB;
constexpr size_t WS_QB = WS_ST + 32 * MiB;
constexpr size_t WS_OI = WS_QB + 16 * MiB;
constexpr size_t WS_AV = WS_OI + 16 * MiB;
constexpr size_t WS_MERGED = WS_SCR;
constexpr size_t WS_SSQ = WS_SCR + 97 * MiB;
constexpr size_t WS_END = WS_SSQ + 13 * MiB;

constexpr int LDS_BYTES = 147456;
constexpr int MISC_OFF = LDS_BYTES - 512;
constexpr int NWAVES = 8;

#define RLX_AGENT __ATOMIC_RELAXED, __HIP_MEMORY_SCOPE_AGENT
#define LDS_WAIT() asm volatile("s_waitcnt lgkmcnt(0)" ::: "memory")
#define VM_WAIT() asm volatile("s_waitcnt vmcnt(0)" ::: "memory")

typedef __bf16 bf16x2_t __attribute__((ext_vector_type(2)));
__device__ __forceinline__ unsigned cvt_pk_bf16(float lo, float hi) { const f32x2 v = {lo, hi}; const bf16x2_t b = __builtin_convertvector(v, bf16x2_t); return __builtin_bit_cast(unsigned, b); }
__device__ __forceinline__ float bflo(unsigned w) { return __uint_as_float(w << 16); }
__device__ __forceinline__ float bfhi(unsigned w) { return __uint_as_float(w & 0xffff0000u); }
__device__ __forceinline__ float fast_exp(float x) { return __builtin_amdgcn_exp2f(x * 1.44269504089f); }
__device__ __forceinline__ float fast_rcp(float x) { return __builtin_amdgcn_rcpf(x); }
__device__ __forceinline__ float wave_sum(float v) {
#pragma unroll
    for (int o = 1; o < 64; o <<= 1) v += __shfl_xor(v, o);
    return v;
}

__device__ __forceinline__ size_t ktm_off(int R, int r, int k) {
    const int rl = r & 127, c = k & 63, st = (rl >> 4) * 2 + (c >> 5), ob = (rl & 15) * 64 + (c & 31) * 2;
    return ((size_t)(k >> 6) * R + (r & ~127)) * 64 + ((st * 1024 + (ob ^ (((ob >> 9) & 1) << 5))) >> 1);
}
__device__ __forceinline__ int perm_slot(int n) { return (n & ~31) | (16 * ((n >> 2) & 1) + 4 * ((n >> 3) & 3) + (n & 3)); }

namespace pg8 {
constexpr int BM = 256, BK = 64, HALF = 128, HTB = HALF * BK * 2, STAGE_BYTES = 8 * HTB, NXCD = 8, WGM = 8;
__host__ __device__ __forceinline__ int lds_byte(int r, int c) { const int st = (r >> 4) * 2 + (c >> 5), rr = r & 15, cc = c & 31, ob = rr * 64 + cc * 2; return st * 1024 + (ob ^ (((ob >> 9) & 1) << 5)); }
__host__ __device__ __forceinline__ void stage_rc(int b, int& R, int& C) { const int st = b / 1024, sb = b % 1024, swz = sb ^ (((sb >> 9) & 1) << 5); R = (st >> 1) * 16 + swz / 64; C = (st & 1) * 32 + (swz % 64) / 2; }
__host__ __device__ __forceinline__ int perm32(int rho) { const int n = rho >> 4, i = rho & 15; return 8 * (i >> 2) + 4 * n + (i & 3); }

struct Unit { int pm, pn, sub; };
struct Gemm { const bf16* A; const bf16* Bt; int ra, rb, nt; };

template <int NSUB> struct TileOrder {
    int nM, nN, nwg, G, c;
    __device__ __forceinline__ void init(int Mr, int Nc, int G_, int c_) { nM = Mr / BM; nN = Nc / BM; nwg = nM * nN; G = G_; c = c_; }
    __device__ __forceinline__ bool next(int i, Unit& u) const {
        const int ti = i / NSUB; u.sub = i - ti * NSUB;
        const long L = (long)ti * G + c; if (L >= nwg) return false;
        int wgid = (int)L; { const int q = nwg / NXCD, r = nwg % NXCD, xcd = wgid % NXCD, off = wgid / NXCD; wgid = (xcd < r ? xcd * (q + 1) : r * (q + 1) + (xcd - r) * q) + off; }
        const int nig = WGM * nN, gid = wgid / nig, fm = gid * WGM, gsz = (nM - fm) < WGM ? (nM - fm) : WGM;
        u.pm = fm + ((wgid % nig) % gsz); u.pn = (wgid % nig) / gsz; return true;
    }
};

__device__ __forceinline__ void ssq_load(const float* ssq, int row, int fq, f32x4& a, f32x4& b) { const float* p = ssq + (size_t)row * 32 + fq * 8; a = *(const f32x4*)p; b = *(const f32x4*)(p + 4); }
__device__ __forceinline__ float ssq_rstd(const f32x4& a, const f32x4& b) { float s = ((a[0] + a[1]) + (a[2] + a[3])) + ((b[0] + b[1]) + (b[2] + b[3])); s += __shfl_xor(s, 16); s += __shfl_xor(s, 32); return rsqrtf(s * (1.0f / D) + EPS); }

__device__ __forceinline__ size_t gf_off(int pm, int n, int pn, int wid, int k16, int lane) { return ((((((size_t)pm * 3 + n) * 8 + pn) * 8 + wid) * 16 + k16) * 64 + lane) * 8; }
constexpr int RSTD_LDS_OFF = 131072;
__device__ __forceinline__ void rstd8(const float* ssq, const LAS float* tab, int tab_pm, const Unit& u, int wr, int fr, int fq, float (&rsv)[8]) {
    if (u.pm == tab_pm) {
#pragma unroll
        for (int i = 0; i < 8; ++i) rsv[i] = tab[(i >> 2) * HALF + wr * 64 + (i & 3) * 16 + fr];
    } else { const int row0 = u.pm * BM + wr * 64 + fr;
#pragma unroll
        for (int hb = 0; hb < 2; ++hb) { f32x4 pa[4], pb[4];
#pragma unroll
            for (int i = 0; i < 4; ++i) ssq_load(ssq, row0 + hb * HALF + i * 16, fq, pa[i], pb[i]);
#pragma unroll
            for (int i = 0; i < 4; ++i) rsv[hb * 4 + i] = ssq_rstd(pa[i], pb[i]); } }
}
struct EpiBf16Rs {
    static constexpr bool PERM = true; static constexpr int NSUB = 1;
    __device__ __forceinline__ int nstores(const Unit& u) const { return 8; }
    bf16* O; int ldc; const float* ssq; bf16* GF; int gate_pn0; bool NT = false; const LAS float* tab = nullptr; int tab_pm = -1; int prod_pn = 0;
    __device__ __forceinline__ void operator()(f32x4 (&acc)[2][2][4][2], const Unit& u, int wr, int wc, int fr, int fq) const {
        asm volatile("" : "+v"(fr), "+v"(fq));
        const int row0 = u.pm * BM + wr * 64 + fr, col0 = u.pn * BM + wc * 32 + 8 * fq;
        float rsv[8];
        if (ssq) { rstd8(ssq, tab, tab_pm, u, wr, fr, fq, rsv);
        } else {
#pragma unroll
            for (int i = 0; i < 8; ++i) rsv[i] = 1.0f; }
        if (u.pn < prod_pn) {
            const int colp = u.pn * HALF + wc * 32 + 8 * fq;
#pragma unroll
            for (int ai = 0; ai < 2; ++ai)
#pragma unroll
                for (int m = 0; m < 4; ++m) { const int row = row0 + ai * HALF + m * 16; const float rs2 = rsv[ai * 4 + m] * rsv[ai * 4 + m];
                    const f32x4 p0 = acc[ai][0][m][0] * acc[ai][1][m][0] * rs2, p1 = acc[ai][0][m][1] * acc[ai][1][m][1] * rs2;
                    u32x4 w; w.x = cvt_pk_bf16(p0[0], p0[1]); w.y = cvt_pk_bf16(p0[2], p0[3]); w.z = cvt_pk_bf16(p1[0], p1[1]); w.w = cvt_pk_bf16(p1[2], p1[3]);
                    __builtin_nontemporal_store(w, (u32x4*)(O + (size_t)row * ldc + colp)); }
            return; }
        if (u.pn >= gate_pn0) {
            const int gt = u.pn - gate_pn0; bf16* gp = GF + gf_off(u.pm, gt >> 3, gt & 7, wr * 4 + wc, 0, fq * 16 + fr);
#pragma unroll
            for (int ai = 0; ai < 2; ++ai)
#pragma unroll
                for (int m = 0; m < 4; ++m) { const float rs = rsv[ai * 4 + m];
#pragma unroll
                    for (int bj = 0; bj < 2; ++bj) { float sg[8];
#pragma unroll
                        for (int n = 0; n < 2; ++n)
#pragma unroll
                            for (int j = 0; j < 4; ++j) { const float a = fminf(fmaxf(acc[ai][bj][m][n][j] * rs, -30.f), 30.f); sg[n * 4 + j] = fast_rcp(1.0f + fast_exp(-a)); }
                        u32x4 w; w.x = cvt_pk_bf16(sg[0], sg[1]); w.y = cvt_pk_bf16(sg[2], sg[3]); w.z = cvt_pk_bf16(sg[4], sg[5]); w.w = cvt_pk_bf16(sg[6], sg[7]);
                        __builtin_nontemporal_store(w, (u32x4*)(gp + (size_t)(((ai * 4 + m) * 2 + bj) * 64) * 8)); } }
            return; }
#pragma unroll
        for (int ai = 0; ai < 2; ++ai)
#pragma unroll
            for (int m = 0; m < 4; ++m) { const int row = row0 + ai * HALF + m * 16; const float rs = rsv[ai * 4 + m]; bf16* rowp = O + (size_t)row * ldc + col0;
#pragma unroll
                for (int bj = 0; bj < 2; ++bj) { const f32x4 v0 = acc[ai][bj][m][0] * rs, v1 = acc[ai][bj][m][1] * rs;
                    u32x4 w; w.x = cvt_pk_bf16(v0[0], v0[1]); w.y = cvt_pk_bf16(v0[2], v0[3]); w.z = cvt_pk_bf16(v1[0], v1[1]); w.w = cvt_pk_bf16(v1[2], v1[3]);
                    if (NT) __builtin_nontemporal_store(w, (u32x4*)(rowp + bj * HALF)); else *(u32x4*)(rowp + bj * HALF) = w; } }
    }
};
struct EpiSwiglu {
    static constexpr bool PERM = true; static constexpr int NSUB = 1;
    __device__ __forceinline__ int nstores(const Unit&) const { return 8; }
    bf16* O; int ldc; const float* ssq; const LAS float* tab = nullptr; int tab_pm = -1;
    __device__ __forceinline__ void operator()(f32x4 (&acc)[2][2][4][2], const Unit& u, int wr, int wc, int fr, int fq) const {
        asm volatile("" : "+v"(fr), "+v"(fq));
        const int row0 = u.pm * BM + wr * 64 + fr, col0 = u.pn * HALF + wc * 32 + 8 * fq;
        float rsv[8]; rstd8(ssq, tab, tab_pm, u, wr, fr, fq, rsv);
#pragma unroll
        for (int ai = 0; ai < 2; ++ai)
#pragma unroll
            for (int m = 0; m < 4; ++m) { const int row = row0 + ai * HALF + m * 16; const float rs = rsv[ai * 4 + m]; float h[8];
#pragma unroll
                for (int n = 0; n < 2; ++n) { const f32x4 g = acc[ai][0][m][n] * rs, up = acc[ai][1][m][n] * rs;
#pragma unroll
                    for (int j = 0; j < 4; ++j) h[n * 4 + j] = g[j] * up[j] * fast_rcp(1.0f + fast_exp(-g[j])); }
                u32x4 w; w.x = cvt_pk_bf16(h[0], h[1]); w.y = cvt_pk_bf16(h[2], h[3]); w.z = cvt_pk_bf16(h[4], h[5]); w.w = cvt_pk_bf16(h[6], h[7]);
                *(u32x4*)(O + ktm_off(M, row, col0)) = w; }
    }
};
struct EpiResid {
    static constexpr bool PERM = false; static constexpr int NSUB = 1;
    __device__ __forceinline__ int nstores(const Unit&) const { return 0; }
    bf16* xb; float* ssq; float scale; float* xout;
    __device__ __forceinline__ void operator()(f32x4 (&acc)[2][2][4][2], const Unit& u, int wr, int wc, int fr, int fq) const {
        asm volatile("" : "+v"(fr), "+v"(fq));
        const int row0 = u.pm * BM + wr * 64 + fr, col0 = u.pn * BM + wc * 32 + 4 * fq, colw = u.pn * BM + wc * 32 + (fq & 1) * 16 + (fq & 2) * 4;
        u32x4 xold[3][2];
#define RESID_LOAD(g) do { const int nr_ = row0 + ((g) >> 2) * HALF + ((g) & 3) * 16; _Pragma("unroll") for (int q = 0; q < 2; ++q) xold[(g) % 3][q] = *(const u32x4*)(xb + ktm_off(M, nr_, colw + q * HALF)); } while (0)
        RESID_LOAD(0); RESID_LOAD(1);
#pragma unroll
        for (int gi = 0; gi < 8; ++gi) { const int ai = gi >> 2, m = gi & 3; const int row = row0 + ai * HALF + m * 16; float ss = 0.f;
            if (gi + 2 < 8) RESID_LOAD(gi + 2);
#pragma unroll
            for (int bj = 0; bj < 2; ++bj) { const u32x4 W = xold[gi % 3][bj];
                const auto lx = __builtin_amdgcn_permlane16_swap(W.x, W.z, false, false); const auto ly = __builtin_amdgcn_permlane16_swap(W.y, W.w, false, false);
                unsigned px[2], py[2];
#pragma unroll
                for (int n = 0; n < 2; ++n) { const unsigned wx = lx[n], wy = ly[n];
                    const f32x4 xo = (f32x4){__uint_as_float(wx << 16), __uint_as_float(wx & 0xffff0000u), __uint_as_float(wy << 16), __uint_as_float(wy & 0xffff0000u)};
                    const f32x4 xn = xo + acc[ai][bj][m][n] * scale;
                    if (xout) *(f32x4*)(xout + (size_t)row * D + col0 + bj * HALF + n * 16) = xn;
                    ss += (xn[0] * xn[0] + xn[1] * xn[1]) + (xn[2] * xn[2] + xn[3] * xn[3]);
                    px[n] = cvt_pk_bf16(xn[0], xn[1]); py[n] = cvt_pk_bf16(xn[2], xn[3]); }
                const auto sx = __builtin_amdgcn_permlane16_swap(px[0], px[1], false, false); const auto sy = __builtin_amdgcn_permlane16_swap(py[0], py[1], false, false);
                *(u32x4*)(xb + ktm_off(M, row, colw + bj * HALF)) = (u32x4){sx[0], sy[0], sx[1], sy[1]}; }
            ss += __shfl_xor(ss, 16); ss += __shfl_xor(ss, 32);
            if (fq == 0) ssq[(size_t)row * 32 + u.pn * 4 + wc] = ss;
            asm volatile("" ::: "memory"); }
#undef RESID_LOAD
    }
};
struct EpiBranch {
    static constexpr bool PERM = true; static constexpr int NSUB = 3;
    __device__ __forceinline__ int nstores(const Unit&) const { return 0; }
    bf16* O; const bf16* GF;
    __device__ __forceinline__ static void up8(const u32x4& w, float (&f)[8]) { f[0] = bflo(w.x); f[1] = bfhi(w.x); f[2] = bflo(w.y); f[3] = bfhi(w.y); f[4] = bflo(w.z); f[5] = bfhi(w.z); f[6] = bflo(w.w); f[7] = bfhi(w.w); }
    __device__ __forceinline__ void operator()(f32x4 (&acc)[2][2][4][2], const Unit& u, int wr, int wc, int fr, int fq) const {
        asm volatile("" : "+v"(fr), "+v"(fq));
        const int s = u.sub; const int wid = wr * 4 + wc, lane = fq * 16 + fr;
        const bf16* ga = GF + gf_off(u.pm, s, u.pn, wid, 0, lane); const bf16* gb = GF + gf_off(u.pm, s < 2 ? s + 1 : s, u.pn, wid, 0, lane);
#pragma unroll
        for (int hb = 0; hb < 2; ++hb) {
            u32x4 wa[8], wb[8];
#pragma unroll
            for (int k = 0; k < 8; ++k) { wa[k] = *(const u32x4*)(ga + (size_t)((hb * 8 + k) * 64) * 8); if (s < 2) wb[k] = *(const u32x4*)(gb + (size_t)((hb * 8 + k) * 64) * 8); }
#pragma unroll
            for (int k = 0; k < 8; ++k) { const int k16 = hb * 8 + k, ai = k16 >> 3, m = (k16 >> 1) & 3, bj = k16 & 1; float f[8], fa[8]; up8(wa[k], fa);
                if (s < 2) { float fb[8]; up8(wb[k], fb);
#pragma unroll
                    for (int j = 0; j < 8; ++j) f[j] = fa[j] * fast_rcp(fb[j]); }
                else {
#pragma unroll
                    for (int j = 0; j < 8; ++j) f[j] = fa[j]; }
#pragma unroll
                for (int n = 0; n < 2; ++n)
#pragma unroll
                    for (int j = 0; j < 4; ++j) acc[ai][bj][m][n][j] *= f[n * 4 + j];
                if (s == 2) { const int row = u.pm * BM + wr * 64 + fr + ai * HALF + m * 16, col = u.pn * BM + wc * 32 + 8 * fq + bj * HALF; const f32x4 v0 = acc[ai][bj][m][0], v1 = acc[ai][bj][m][1];
                    u32x4 w; w.x = cvt_pk_bf16(v0[0], v0[1]); w.y = cvt_pk_bf16(v0[2], v0[3]); w.z = cvt_pk_bf16(v1[0], v1[1]); w.w = cvt_pk_bf16(v1[2], v1[3]);
                    *(u32x4*)(O + ktm_off(M, row, col)) = w; } } }
    }
};

__device__ __forceinline__ void fill_rstd_table(LAS float* tab, const float* ssq, int pm) {
    int t = threadIdx.x; asm volatile("" : "+v"(t));
    const float* p = ssq + ((size_t)pm * BM + (t >> 1)) * 32 + (t & 1) * 16;
    const f32x4 a = *(const f32x4*)p, b = *(const f32x4*)(p + 4), c = *(const f32x4*)(p + 8), d = *(const f32x4*)(p + 12);
    float sum = (((a[0] + a[1]) + (a[2] + a[3])) + ((b[0] + b[1]) + (b[2] + b[3]))) + (((c[0] + c[1]) + (c[2] + c[3])) + ((d[0] + d[1]) + (d[2] + d[3])));
    sum += __shfl_xor(sum, 1);
    if ((t & 1) == 0) tab[t >> 1] = rsqrtf(sum * (1.0f / D) + EPS);
    __syncthreads();
}
template <class Epi, class Sched, bool ALIGN_EPI>
__device__ __forceinline__ void gemm_phase(LAS unsigned char* lds, const Gemm g, const Sched& S, const Epi& E) {
    int tid = threadIdx.x; asm volatile("" : "+v"(tid));
    const int wid = __builtin_amdgcn_readfirstlane(tid >> 6), lane = tid & 63, wr = wid >> 2, wc = wid & 3, fr = lane & 15, fq = lane >> 4;
    const int nt = g.nt;
    unsigned voffA[2], voffB[2];
#pragma unroll
    for (int i = 0; i < 2; ++i) { voffA[i] = (unsigned)(tid * 16 + i * 8192); voffB[i] = voffA[i]; }
    const size_t kstepA = (size_t)g.ra * 128, kstepB = (size_t)g.rb * 128;
    constexpr size_t hstepA = (size_t)HALF * 128, hstepB = hstepA, tstepA = 2 * hstepA, tstepB = tstepA;
    const size_t sstepA = (size_t)g.nt * kstepA, sstepB = (size_t)g.nt * kstepB;
    const unsigned ldsw = (unsigned)wid * 1024u;
    const int aoff = lds_byte(wr * 64 + fr, fq * 8), boff = lds_byte(wc * 32 + fr, fq * 8);
#define PG8_SA(b, h) (((b) * 2 + (h)) * HTB)
#define PG8_SB(b, h) ((4 + (b) * 2 + (h)) * HTB)
#define PG8_STAGE(bufoff, gbase, voff) do { _Pragma("unroll") for (int _i = 0; _i < 2; ++_i) \
        __builtin_amdgcn_global_load_lds((const unsigned*)((const char*)(gbase) + (voff)[_i]), (LAS unsigned*)(lds + (bufoff) + ldsw + _i * 8192), 16, 0, 0); } while (0)
#define PG8_LDA(dst, b, h) do { _Pragma("unroll") for (int m = 0; m < 4; ++m) _Pragma("unroll") for (int k = 0; k < 2; ++k) dst[m][k] = *(const LAS bf16x8*)(lds + PG8_SA(b, h) + aoff + m * 2048 + k * 1024); } while (0)
#define PG8_LDB(dst, b, h) do { _Pragma("unroll") for (int n = 0; n < 2; ++n) _Pragma("unroll") for (int k = 0; k < 2; ++k) dst[n][k] = *(const LAS bf16x8*)(lds + PG8_SB(b, h) + boff + n * 2048 + k * 1024); } while (0)
#define PG8_MMA(ai, bj, At, Bt) do { __builtin_amdgcn_s_setprio(1); _Pragma("unroll") for (int m = 0; m < 4; ++m) _Pragma("unroll") for (int n = 0; n < 2; ++n) _Pragma("unroll") for (int k = 0; k < 2; ++k) \
        acc[ai][bj][m][n] = __builtin_amdgcn_mfma_f32_16x16x32_bf16(Bt[n][k], At[m][k], acc[ai][bj][m][n], 0, 0, 0); __builtin_amdgcn_s_setprio(0); } while (0)
#define PG8_WAIT_V(n) asm volatile("s_waitcnt vmcnt(" #n ")" ::: "memory")
#define PG8_WAIT_L(n) asm volatile("s_waitcnt lgkmcnt(" #n ")" ::: "memory")
#define PG8_BAR __builtin_amdgcn_s_barrier()
#define PG8_SCHED __builtin_amdgcn_sched_barrier(0)
    Unit cur, nxt; int ui = 0; int rs = 0;
    if (!S.next(0, cur)) return;
    f32x4 acc[2][2][4][2];
#pragma unroll
    for (int a = 0; a < 2; ++a)
#pragma unroll
        for (int b = 0; b < 2; ++b)
#pragma unroll
            for (int m = 0; m < 4; ++m)
#pragma unroll
                for (int n = 0; n < 2; ++n) acc[a][b][m][n] = (f32x4){0.f, 0.f, 0.f, 0.f};
    bf16x8 At[4][2], B0[2][2], B1[2][2];
    const char* cA = (const char*)g.A + (size_t)cur.pm * tstepA + (size_t)cur.sub * sstepA; const char* cB = (const char*)g.Bt + (size_t)cur.pn * tstepB + (size_t)cur.sub * sstepB;
    PG8_STAGE(PG8_SB(0, 0), cB, voffB); PG8_STAGE(PG8_SB(0, 1), cB + hstepB, voffB); PG8_STAGE(PG8_SA(0, 0), cA, voffA); PG8_STAGE(PG8_SA(0, 1), cA + hstepA, voffA);
    if (wr == 1) PG8_BAR;
    PG8_WAIT_V(2); PG8_BAR;
    PG8_STAGE(PG8_SB(1, 0), cB + kstepB, voffB); PG8_STAGE(PG8_SA(1, 0), cA + kstepA, voffA); PG8_STAGE(PG8_SB(1, 1), cB + hstepB + kstepB, voffB);
    PG8_WAIT_V(6); PG8_BAR;
    for (;;) {
        const bool has_next = S.next(ui + 1, nxt);
        const char* nA = has_next ? (const char*)g.A + (size_t)nxt.pm * tstepA + (size_t)nxt.sub * sstepA : cA; const char* nB = has_next ? (const char*)g.Bt + (size_t)nxt.pn * tstepB + (size_t)nxt.sub * sstepB : cB;
#define PG8_ITER(t, W1, W2, W3) do { \
            const bool last = ((t) == nt - 2); \
            const char* a1 = cA + (size_t)((t) + 1) * kstepA; \
            const char* a2 = last ? nA : cA + (size_t)((t) + 2) * kstepA; const char* b2 = last ? nB : cB + (size_t)((t) + 2) * kstepB; \
            const char* a3 = a2 + kstepA; const char* b3 = b2 + kstepB; \
              \
            PG8_LDB(B0, 0, 0); PG8_LDB(B1, 0, 1); PG8_SCHED; PG8_LDA(At, 0, 0); PG8_STAGE(PG8_SA(1, 1), a1 + hstepA, voffA); \
            PG8_WAIT_V(W1); PG8_WAIT_L(0); PG8_BAR; PG8_MMA(0, 0, At, B0); PG8_MMA(0, 1, At, B1); PG8_BAR; PG8_SCHED; \
              \
            PG8_LDA(At, 0, 1); PG8_STAGE(PG8_SB(0, 0), b2, voffB); PG8_STAGE(PG8_SB(0, 1), b2 + hstepB, voffB); PG8_STAGE(PG8_SA(0, 0), a2, voffA); \
            PG8_WAIT_V(W2); PG8_WAIT_L(0); PG8_BAR; PG8_MMA(1, 0, At, B0); PG8_MMA(1, 1, At, B1); PG8_BAR; PG8_SCHED; \
              \
            PG8_LDB(B0, 1, 0); PG8_LDB(B1, 1, 1); PG8_SCHED; PG8_LDA(At, 1, 0); PG8_STAGE(PG8_SA(0, 1), a2 + hstepA, voffA); \
            PG8_WAIT_V(W3); PG8_WAIT_L(0); PG8_BAR; PG8_MMA(0, 0, At, B0); PG8_MMA(0, 1, At, B1); PG8_BAR; PG8_SCHED; \
              \
            PG8_LDA(At, 1, 1); PG8_STAGE(PG8_SB(1, 0), b3, voffB); PG8_STAGE(PG8_SB(1, 1), b3 + hstepB, voffB); PG8_STAGE(PG8_SA(1, 0), a3, voffA); \
            PG8_WAIT_V(8); PG8_WAIT_L(0); PG8_BAR; PG8_MMA(1, 0, At, B0); PG8_MMA(1, 1, At, B1); PG8_BAR; PG8_SCHED; } while (0)
        int t0 = 0;
        if (rs) { PG8_ITER(0, 16, 16, 8); t0 = 2; }
        for (int t = t0; t < nt; t += 2) PG8_ITER(t, 8, 8, 8);
#undef PG8_ITER
        if constexpr (ALIGN_EPI) { if (wr == 0) PG8_BAR; }
        E(acc, cur, wr, wc, fr, fq);
        rs = E.nstores(cur);
        if (!has_next) break;
        if (cur.sub == Epi::NSUB - 1) {
#pragma unroll
            for (int a = 0; a < 2; ++a)
#pragma unroll
                for (int b = 0; b < 2; ++b)
#pragma unroll
                    for (int m = 0; m < 4; ++m)
#pragma unroll
                        for (int n = 0; n < 2; ++n) { acc[a][b][m][n] = (f32x4){0.f, 0.f, 0.f, 0.f}; asm volatile("" : "+v"(acc[a][b][m][n])); }
        }
        cur = nxt; cA = nA; cB = nB; ++ui;
        if constexpr (ALIGN_EPI) { if (wr == 1) PG8_BAR; }
    }
    PG8_WAIT_V(0);
    if constexpr (!ALIGN_EPI) { if (wr == 0) PG8_BAR; }
    PG8_BAR;
#undef PG8_SA
#undef PG8_SB
#undef PG8_STAGE
#undef PG8_LDA
#undef PG8_LDB
#undef PG8_MMA
#undef PG8_WAIT_V
#undef PG8_WAIT_L
#undef PG8_BAR
#undef PG8_SCHED
}
}

#define XB_TMO      128
#define XB_XCNT(j)  (256  + 64 * (j))
#define XB_XSUB(j)  (1280 + 64 * (j))
#define XB_XGEN(j)  (2304 + 64 * (j))
#define XB_TOP      3328
#define XB_TOPGEN   3392
#define XCD_BAR_WORDS 3456
#define XB_SPIN_CAP (1u << 18)
__device__ __forceinline__ unsigned xb_ld(unsigned* p)              { return __hip_atomic_load(p, __ATOMIC_RELAXED, __HIP_MEMORY_SCOPE_AGENT); }
__device__ __forceinline__ unsigned xb_add(unsigned* p, unsigned v) { return __hip_atomic_fetch_add(p, v, __ATOMIC_RELAXED, __HIP_MEMORY_SCOPE_AGENT); }
__device__ __forceinline__ unsigned xb_xcc_id() { return (unsigned)__builtin_amdgcn_s_getreg((3 << 11) | 20) & 0xFu; }
#define XB_SPIN(cond, bar) do { unsigned _sp = 0; while (cond) { __builtin_amdgcn_s_sleep(1); \
    if ((++_sp & 255u) == 0u) { if (xb_ld(&(bar)[XB_TMO])) break; if (_sp > XB_SPIN_CAP) { atomicAdd(&(bar)[XB_TMO], 1u); break; } } } } while (0)
struct XcdBarrier { unsigned* bar; unsigned x; volatile LAS unsigned* st; };
__device__ __forceinline__ XcdBarrier xcd_barrier_post(unsigned* bar, volatile LAS unsigned* st) {
    XcdBarrier b; b.bar = bar; b.x = xb_xcc_id(); b.st = st;
    if (threadIdx.x == 0) (void)xb_add(&bar[XB_XCNT(b.x)], 1u);
    return b;
}
__device__ __forceinline__ void xcd_barrier_complete(unsigned* bar, unsigned x, unsigned& nloc, unsigned& nx) {
    const unsigned G = gridDim.x * gridDim.y * gridDim.z;
    unsigned sum, cnt, mine, sp = 0u;
    for (;;) {
        sum = 0u; cnt = 0u; mine = 0u;
#pragma unroll
        for (unsigned j = 0; j < 16; ++j) { const unsigned c = xb_ld(&bar[XB_XCNT(j)]); sum += c; cnt += (c > 0u) ? 1u : 0u; mine = (j == x) ? c : mine; }
        if (sum == G) break;
        __builtin_amdgcn_s_sleep(1);
        if ((++sp & 255u) == 0u) { if (xb_ld(&bar[XB_TMO])) break; if (sp > XB_SPIN_CAP) { atomicAdd(&bar[XB_TMO], 1u); break; } }
    }
    nloc = mine > 0u ? mine : 1u; nx = cnt > 0u ? cnt : 1u;
}
__device__ __forceinline__ void xcd_barrier(const XcdBarrier& b) {
    asm volatile("s_waitcnt vmcnt(0)" ::: "memory");
    __syncthreads();
    if (threadIdx.x == 0) {
        unsigned* bar = b.bar;
        __builtin_amdgcn_s_waitcnt(0);
        unsigned nloc = b.st[0], nx = b.st[1];
        if (nloc == 0u) { xcd_barrier_complete(bar, b.x, nloc, nx); b.st[0] = nloc; b.st[1] = nx; }
        const unsigned old = xb_add(&bar[XB_XSUB(b.x)], 1u);
        const unsigned gen = old / nloc;
        if (old + 1u == (gen + 1u) * nloc) {
            __builtin_amdgcn_fence(__ATOMIC_RELEASE, "agent");
            asm volatile("s_waitcnt vmcnt(0)" ::: "memory");
            const unsigned og = xb_add(&bar[XB_TOP], 1u);
            const unsigned tg = og / nx;
            if (og + 1u == (tg + 1u) * nx) xb_add(&bar[XB_TOPGEN], 1u);
            else XB_SPIN(xb_ld(&bar[XB_TOPGEN]) == tg, bar);
            __builtin_amdgcn_fence(__ATOMIC_ACQUIRE, "agent");
            xb_add(&bar[XB_XGEN(b.x)], 1u);
            asm volatile("s_waitcnt vmcnt(0)" ::: "memory");
        } else {
            XB_SPIN(xb_ld(&bar[XB_XGEN(b.x)]) == gen, bar);
            __builtin_amdgcn_fence(__ATOMIC_ACQUIRE, "agent");
            asm volatile("s_waitcnt vmcnt(0)" ::: "memory");
        }
    }
    __syncthreads();
}


namespace pg8 {
struct EpiResidFin {
    static constexpr bool PERM = false; static constexpr int NSUB = 1;
    __device__ __forceinline__ int nstores(const Unit&) const { return 0; }
    const bf16* xb; float* out; float* ssq; float scale; const float* gain; unsigned* bar; unsigned* cnt;
    __device__ __forceinline__ void operator()(f32x4 (&acc)[2][2][4][2], const Unit& u, int wr, int wc, int fr, int fq) const {
        asm volatile("" : "+v"(fr), "+v"(fq));
        const int row0 = u.pm * BM + wr * 64 + fr, col0 = u.pn * BM + wc * 32 + 4 * fq, colw = u.pn * BM + wc * 32 + (fq & 1) * 16 + (fq & 2) * 4;
        u32x4 xold[3][2];
#define RESID_LOAD(g) do { const int nr_ = row0 + ((g) >> 2) * HALF + ((g) & 3) * 16; _Pragma("unroll") for (int q = 0; q < 2; ++q) xold[(g) % 3][q] = *(const u32x4*)(xb + ktm_off(M, nr_, colw + q * HALF)); } while (0)
        RESID_LOAD(0); RESID_LOAD(1);
#pragma unroll
        for (int gi = 0; gi < 8; ++gi) { const int ai = gi >> 2, m = gi & 3; const int row = row0 + ai * HALF + m * 16; float ss = 0.f;
            if (gi + 2 < 8) RESID_LOAD(gi + 2);
#pragma unroll
            for (int bj = 0; bj < 2; ++bj) { const u32x4 W = xold[gi % 3][bj];
                const auto lx = __builtin_amdgcn_permlane16_swap(W.x, W.z, false, false); const auto ly = __builtin_amdgcn_permlane16_swap(W.y, W.w, false, false);
#pragma unroll
                for (int n = 0; n < 2; ++n) { const unsigned wx = lx[n], wy = ly[n];
                    const f32x4 xo = (f32x4){__uint_as_float(wx << 16), __uint_as_float(wx & 0xffff0000u), __uint_as_float(wy << 16), __uint_as_float(wy & 0xffff0000u)};
                    const f32x4 xn = xo + acc[ai][bj][m][n] * scale; acc[ai][bj][m][n] = xn;
                    ss += (xn[0] * xn[0] + xn[1] * xn[1]) + (xn[2] * xn[2] + xn[3] * xn[3]); } }
            ss += __shfl_xor(ss, 16); ss += __shfl_xor(ss, 32);
            if (fq == 0) __hip_atomic_store((__attribute__((address_space(1))) float*)(ssq + (size_t)row * 32 + u.pn * 4 + wc), ss, __ATOMIC_RELAXED, __HIP_MEMORY_SCOPE_AGENT); }
#undef RESID_LOAD
        asm volatile("s_waitcnt vmcnt(0)" ::: "memory");
        __syncthreads();
        if (threadIdx.x == 0) {
            (void)xb_add(&cnt[u.pm * 16], 1u);
            XB_SPIN(xb_ld(&cnt[u.pm * 16]) < (unsigned)(D / BM), bar);
            __builtin_amdgcn_fence(__ATOMIC_ACQUIRE, "agent");
        }
        __syncthreads();
        f32x4 gn[4];
#pragma unroll
        for (int q = 0; q < 4; ++q) gn[q] = *(const f32x4*)(gain + col0 + (q >> 1) * HALF + (q & 1) * 16);
#pragma unroll
        for (int gi = 0; gi < 8; ++gi) { const int ai = gi >> 2, m = gi & 3; const int row = row0 + ai * HALF + m * 16;
            const f32x4 pa = *(const f32x4*)(ssq + (size_t)row * 32 + fq * 8), pb = *(const f32x4*)(ssq + (size_t)row * 32 + fq * 8 + 4);
            float t = ((pa[0] + pa[1]) + (pa[2] + pa[3])) + ((pb[0] + pb[1]) + (pb[2] + pb[3]));
            t += __shfl_xor(t, 16); t += __shfl_xor(t, 32);
            const float rs = rsqrtf(t * (1.0f / D) + EPS);
#pragma unroll
            for (int bj = 0; bj < 2; ++bj)
#pragma unroll
                for (int n = 0; n < 2; ++n) *(f32x4*)(out + (size_t)row * D + col0 + bj * HALF + n * 16) = acc[ai][bj][m][n] * rs * gn[bj * 2 + n]; }
    }
};
}

struct Args { const float* in[20]; float* out; unsigned char* ws; int ph_lo, ph_hi; };
struct Frame {
    LAS unsigned char* lds;
    int vcu, G;
    const float* const* in;
    float* out; unsigned char* ws;
};
#define IDS() int tid_ = threadIdx.x; asm volatile("" : "+v"(tid_)); const int TID = tid_, LANE = tid_ & 63, WAVE = __builtin_amdgcn_readfirstlane(tid_ >> 6)
__device__ __forceinline__ bf16* wl_ptr(unsigned char* ws, int l, size_t off) { return (bf16*)(ws + WS_WL + (size_t)l * WL_SIZE + off); }

template <bool GAIN>
__device__ __forceinline__ void tr_item(const float* W, int N, int k0, int n0, const float* gain, bf16* WT, size_t ldd, int drow0, int dk0, int lane, bool PERMB) {
    const int kc = lane & 7, nn = lane >> 3;
    const float* src = W + (size_t)(k0 + 8 * kc) * N + n0 + 4 * nn;
    f32x4 v[8];
#pragma unroll
    for (int j = 0; j < 8; ++j) v[j] = __builtin_nontemporal_load((const f32x4*)(src + (size_t)j * N));
    if (GAIN) { const f32x4 g0 = *(const f32x4*)(gain + k0 + 8 * kc), g1 = *(const f32x4*)(gain + k0 + 8 * kc + 4);
#pragma unroll
        for (int j = 0; j < 4; ++j) { v[j] = v[j] * g0[j]; v[4 + j] = v[4 + j] * g1[j]; } }
#pragma unroll
    for (int e = 0; e < 4; ++e) { u32x4 o; o.x = cvt_pk_bf16(v[0][e], v[1][e]); o.y = cvt_pk_bf16(v[2][e], v[3][e]); o.z = cvt_pk_bf16(v[4][e], v[5][e]); o.w = cvt_pk_bf16(v[6][e], v[7][e]);
        const int nrow = drow0 + 4 * nn + e;
        *(u32x4*)(WT + ktm_off((int)ldd, PERMB ? perm_slot(nrow) : nrow, dk0 + 8 * kc)) = o; }
}
__device__ __forceinline__ void p_prologue(Frame& F, int l_lo, int l_hi, bool misc) {
    IDS();
    const int gw = F.vcu * NWAVES + WAVE, NGW = F.G * NWAVES;
    constexpr int I_G = 32 * 176, I_D = 88 * 64, I_IN = 32 * 448, I_BR = 3 * 16 * 64, I_O = 32 * 64;
    constexpr int I_LAYER = 4 * I_G + 2 * I_D + I_IN + I_BR + I_O, I_KV = 32 * 64;
    const int nL = (l_hi - l_lo) * I_LAYER, nJ = nL + (misc ? DEPTH * I_KV : 0);
    for (int j = gw; j < nJ; j += NGW) {
        const int it = j < nL ? l_lo * I_LAYER + j : DEPTH * I_LAYER + (j - nL);
        const float* W; const float* gain = nullptr; bf16* WT; int N, k0, n0, drow0, dk0; size_t ldd; bool permb = true;
        if (it < DEPTH * I_LAYER) {
            const int l = it / I_LAYER; int r = it - l * I_LAYER;
            if (r < 2 * I_G || (r >= 2 * I_G + I_D + I_IN + I_BR + I_O && r < 4 * I_G + I_D + I_IN + I_BR + I_O)) {
                const bool second = r >= 2 * I_G; if (second) r -= 2 * I_G + I_D + I_IN + I_BR + I_O;
                const bool up = r >= I_G; if (up) r -= I_G;
                const int kb = r / 176, nb = r - kb * 176; N = FF; k0 = kb * 64; n0 = nb * 32;
                W = F.in[second ? (up ? 17 : 16) : (up ? 4 : 3)] + (size_t)l * D * FF; gain = F.in[second ? 15 : 2] + l * D;
                WT = wl_ptr(F.ws, l, second ? WL_GU2 : WL_GU1); ldd = 2 * FF; drow0 = (n0 >> 7) * 256 + (n0 & 127) + (up ? 128 : 0); dk0 = k0;
            } else if (r < 2 * I_G + I_D || r >= 4 * I_G + I_D + I_IN + I_BR + I_O) {
                const bool second = r >= 2 * I_G + I_D; r -= second ? (4 * I_G + I_D + I_IN + I_BR + I_O) : (2 * I_G);
                if (second && l >= 1 && LAZY_D2) continue;
                const int kb = r / 64, nb = r - kb * 64; N = D; k0 = kb * 64; n0 = nb * 32;
                W = F.in[second ? 18 : 5] + (size_t)l * FF * D; WT = wl_ptr(F.ws, l, second ? WL_D2 : WL_D1); ldd = D; drow0 = n0; dk0 = k0; permb = false;
            } else { r -= 2 * I_G + I_D;
                if (r < I_IN) { const int kb = r / 448, nb = r - kb * 448; N = INC; k0 = kb * 64; n0 = nb * 32;
                    W = F.in[7] + (size_t)l * D * INC; gain = F.in[6] + l * D; WT = wl_ptr(F.ws, l, WL_IN); ldd = INC; dk0 = k0;
                    drow0 = n0 < 1024 ? (n0 >> 7) * 256 + (n0 & 127) : n0 < 2048 ? n0 + 1024 : n0 < 3072 ? ((n0 - 2048) >> 7) * 256 + 128 + (n0 & 127) : n0; }
                else { r -= I_IN;
                    if (r < I_BR) { const int s = r / 1024, rr = r - s * 1024, kb = rr / 64, nb = rr - kb * 64; N = D; k0 = kb * 64; n0 = nb * 32;
                        W = F.in[13] + (size_t)(l * 3 + s) * NBW * D; WT = wl_ptr(F.ws, l, WL_BR); ldd = D; drow0 = n0; dk0 = s * NBW + k0; }
                    else { r -= I_BR; const int kb = r / 64, nb = r - kb * 64; N = D; k0 = kb * 64; n0 = nb * 32;
                        W = F.in[14] + (size_t)l * D * D; WT = wl_ptr(F.ws, l, WL_O); ldd = D; drow0 = n0; dk0 = k0; permb = false; } } }
        } else {
            int r = it - DEPTH * I_LAYER; const int l = r / I_KV; r -= l * I_KV; const int kb = r / 64, nb = r - kb * 64; N = D; k0 = kb * 64; n0 = nb * 32;
            W = F.in[12] + (size_t)l * D * D; gain = F.in[11] + l * D; ldd = 4096; dk0 = k0;
            if (n0 < 1024) { WT = (bf16*)(F.ws + WS_WK); drow0 = l * 1024 + n0; } else { WT = (bf16*)(F.ws + WS_WV); drow0 = l * 1024 + n0 - 1024; permb = false; }
        }
        if (gain) tr_item<true>(W, N, k0, n0, gain, WT, ldd, drow0, dk0, LANE, permb);
        else tr_item<false>(W, N, k0, n0, gain, WT, ldd, drow0, dk0, LANE, permb);
    }
    if (!misc) return;
    float* ssq0 = (float*)(F.ws + WS_SSQ);
    bf16* xb = (bf16*)(F.ws + WS_XB); bf16* memb = (bf16*)(F.ws + WS_MEMB);
    for (int row = gw; row < M + MEMR; row += NGW) {
        const bool isx = row < M; const float* src = isx ? F.in[0] + (size_t)row * D : F.in[1] + (size_t)(row - M) * D;
        f32x4 v[8]; float s = 0.f;
#pragma unroll
        for (int j = 0; j < 8; ++j) { v[j] = *(const f32x4*)(src + 4 * LANE + 256 * j); s += (v[j][0] * v[j][0] + v[j][1] * v[j][1]) + (v[j][2] * v[j][2] + v[j][3] * v[j][3]); }
        s = wave_sum(s);
        float rs = 1.0f; bf16* dst; int rr, RR;
        if (isx) { if (LANE < 32) ssq0[(size_t)row * 32 + LANE] = (LANE == 0) ? s : 0.f; dst = xb; rr = row; RR = M; } else { rs = rsqrtf(s * (1.0f / D) + EPS); dst = memb; rr = row - M; RR = MEMR; }
#pragma unroll
        for (int j = 0; j < 8; ++j) { u32x2 w; w.x = cvt_pk_bf16(v[j][0] * rs, v[j][1] * rs); w.y = cvt_pk_bf16(v[j][2] * rs, v[j][3] * rs); *(u32x2*)(dst + ktm_off(RR, rr, 4 * LANE + 256 * j)) = w;
            if (!isx) *(u32x2*)((bf16*)(F.ws + WS_MEMBP) + ktm_off(RR, perm_slot(rr), 4 * LANE + 256 * j)) = w; }
    }
    float* lbv = (float*)(F.ws + WS_LBV);
    for (int d = gw * 64 + LANE; d < 1024; d += NGW * 64) {
        const float a0 = F.in[9][d], a1 = F.in[9][1024 + d], a2 = F.in[9][2048 + d], a3 = F.in[9][3072 + d];
        const float mx = fmaxf(fmaxf(a0, a1), fmaxf(a2, a3));
        const float e0 = expf(a0 - mx), e1 = expf(a1 - mx), e2 = expf(a2 - mx), e3 = expf(a3 - mx), inv = 1.0f / (e0 + e1 + e2 + e3);
        lbv[d] = 0.f; lbv[1024 + d] = e1 * inv; lbv[2048 + d] = (e1 + e2) * inv; lbv[3072 + d] = (e1 + e2 + e3) * inv;
    }
}

__device__ __forceinline__ void p_convert_d2(Frame& F, int l, int hf) {
    IDS();
    const int cb = (int)blockIdx.x - F.G / 2; if (cb < 0) return;
    const int nw = (F.G - F.G / 2) * NWAVES; constexpr int I_D = 88 * 64;
    const float* W = F.in[18] + (size_t)l * FF * D; bf16* WT = wl_ptr(F.ws, l, WL_D2);
    for (int r = hf * (I_D / 2) + cb * NWAVES + WAVE; r < (hf + 1) * (I_D / 2); r += nw) { const int kb = r / 64, nb = r - kb * 64;
        tr_item<false>(W, D, kb * 64, nb * 32, nullptr, WT, D, nb * 32, kb * 64, LANE, false); }
}

constexpr int AT_STRIDE = 528;
__device__ __forceinline__ void p_attn(Frame& F, int l) {
    IDS();
    const bf16* P = (const bf16*)(F.ws + WS_P); const bf16* KB = (const bf16*)(F.ws + WS_KB); const bf16* VT = (const bf16*)(F.ws + WS_VT); bf16* YC = (bf16*)(F.ws + WS_YCAT);
    const int g = LANE >> 4, fr = LANE & 15;
    for (int unit = blockIdx.x; unit < BATCH * 4 * 16; unit += F.G) {
        const int b = unit >> 6, h = (unit >> 4) & 3, qb = unit & 15;
        const bf16* Kg = KB + (size_t)(b * MEML) * 4096 + l * 1024 + h * 256;
        const int srow = TID >> 5, sc16 = TID & 31;
        {   u32x4 kr[16];
#pragma unroll
            for (int i = 0; i < 16; ++i) kr[i] = *(const u32x4*)(Kg + (size_t)(srow + 16 * i) * 4096 + sc16 * 8);
#pragma unroll
            for (int i = 0; i < 16; ++i) *(LAS u32x4*)(F.lds + (srow + 16 * i) * AT_STRIDE + sc16 * 16) = kr[i]; }
        const bf16* Vg = VT + (size_t)(l * 1024 + h * 256) * 1024 + b * MEML;
        u32x4 vr[8];
#pragma unroll
        for (int i = 0; i < 8; ++i) vr[i] = *(const u32x4*)(Vg + (size_t)(srow + 16 * i) * 1024 + sc16 * 8);
        const int row = b * SEQ + qb * 128 + 16 * WAVE + fr;
        const bf16* Qg = P + (size_t)row * PST + C_AQ + h * 256 + g * 8;
        bf16x8 qf[8];
#pragma unroll
        for (int ks = 0; ks < 8; ++ks) qf[ks] = *(const bf16x8*)(Qg + ks * 32);
        __syncthreads();
        f32x4 s[16];
#pragma unroll
        for (int blk = 0; blk < 16; ++blk) { s[blk] = (f32x4){0.f, 0.f, 0.f, 0.f};
#pragma unroll
            for (int ks = 0; ks < 8; ++ks) { const bf16x8 a = *(const LAS bf16x8*)(F.lds + (16 * blk + fr) * AT_STRIDE + ks * 64 + g * 16); s[blk] = __builtin_amdgcn_mfma_f32_16x16x32_bf16(a, qf[ks], s[blk], 0, 0, 0); }
            if (blk & 1) asm volatile("" ::: "memory"); }
        u32x4 v2[8];
#pragma unroll
        for (int i = 0; i < 8; ++i) v2[i] = *(const u32x4*)(Vg + (size_t)(srow + 16 * (i + 8)) * 1024 + sc16 * 8);
        float mx = -3.0e38f;
#pragma unroll
        for (int blk = 0; blk < 16; ++blk) mx = fmaxf(mx, fmaxf(fmaxf(s[blk][0], s[blk][1]), fmaxf(s[blk][2], s[blk][3])));
        mx = fmaxf(mx, __shfl_xor(mx, 16)); mx = fmaxf(mx, __shfl_xor(mx, 32));
        float sum = 0.f;
#pragma unroll
        for (int blk = 0; blk < 16; ++blk)
#pragma unroll
            for (int r = 0; r < 4; ++r) { const float p = fast_exp((s[blk][r] - mx) * 0.0625f); s[blk][r] = p; sum += p; }
        sum += __shfl_xor(sum, 16); sum += __shfl_xor(sum, 32);
        bf16x8 pf[8];
#pragma unroll
        for (int i = 0; i < 8; ++i) { u32x4 w; w.x = cvt_pk_bf16(s[2 * i][0], s[2 * i][1]); w.y = cvt_pk_bf16(s[2 * i][2], s[2 * i][3]); w.z = cvt_pk_bf16(s[2 * i + 1][0], s[2 * i + 1][1]); w.w = cvt_pk_bf16(s[2 * i + 1][2], s[2 * i + 1][3]); pf[i] = __builtin_bit_cast(bf16x8, w); }
        __syncthreads();
        {
#pragma unroll
            for (int i = 0; i < 8; ++i) *(LAS u32x4*)(F.lds + (srow + 16 * i) * AT_STRIDE + sc16 * 16) = vr[i];
#pragma unroll
            for (int i = 0; i < 8; ++i) *(LAS u32x4*)(F.lds + (srow + 16 * (i + 8)) * AT_STRIDE + sc16 * 16) = v2[i]; }
        __syncthreads();
        const float inv = 1.0f / sum;
        const int ocol = 2 * NBW + h * 256 + 4 * g;
#pragma unroll
        for (int db = 0; db < 16; ++db) { f32x4 o = (f32x4){0.f, 0.f, 0.f, 0.f};
#pragma unroll
            for (int i = 0; i < 8; ++i) { const LAS unsigned char* vp = F.lds + (16 * db + fr) * AT_STRIDE + (32 * i + 4 * g) * 2;
                const u32x2 lo = *(const LAS u32x2*)vp, hi = *(const LAS u32x2*)(vp + 32); u32x4 w; w.x = lo.x; w.y = lo.y; w.z = hi.x; w.w = hi.y;
                o = __builtin_amdgcn_mfma_f32_16x16x32_bf16(__builtin_bit_cast(bf16x8, w), pf[i], o, 0, 0, 0); }
            u32x2 w; w.x = cvt_pk_bf16(o[0] * inv, o[1] * inv); w.y = cvt_pk_bf16(o[2] * inv, o[3] * inv); *(u32x2*)(YC + ktm_off(M, row, ocol + 16 * db)) = w; }
        __syncthreads();
    }
}

__device__ __forceinline__ void ld8f(const bf16* p, float (&f)[8]) { const u32x4 w = *(const u32x4*)p; f[0] = bflo(w.x); f[1] = bfhi(w.x); f[2] = bflo(w.y); f[3] = bfhi(w.y); f[4] = bflo(w.z); f[5] = bfhi(w.z); f[6] = bflo(w.w); f[7] = bfhi(w.w); }
__device__ __forceinline__ void cv8f(const u32x4 w, float (&f)[8]) { f[0] = bflo(w.x); f[1] = bfhi(w.x); f[2] = bflo(w.y); f[3] = bfhi(w.y); f[4] = bflo(w.z); f[5] = bfhi(w.z); f[6] = bflo(w.w); f[7] = bfhi(w.w); }
__device__ __forceinline__ void p_conv(Frame& F, int l) {
    IDS();
    const bf16* P = (const bf16*)(F.ws + WS_P); bf16* YC = (bf16*)(F.ws + WS_YCAT); const float* cw = F.in[8] + (size_t)l * 3 * NBW;
    const int c8 = (TID & 127) * 8, stride = F.G * 512;
    f32x4 wt[3][2];
#pragma unroll
    for (int j = 0; j < 3; ++j) { wt[j][0] = *(const f32x4*)(cw + j * NBW + c8); wt[j][1] = *(const f32x4*)(cw + j * NBW + c8 + 4); }
    for (int idx0 = F.vcu * 512 + TID; idx0 < M * 128; idx0 += 4 * stride) {
        u32x4 pv[4][3], bw[4];
#pragma unroll
        for (int q = 0; q < 4; ++q) { const int idx = idx0 + q * stride; const int row = idx >> 7, t = row & (SEQ - 1);
            if (idx < M * 128) {
#pragma unroll
                for (int j = 0; j < 3; ++j) pv[q][j] = (t - 2 + j >= 0) ? *(const u32x4*)(P + (size_t)(row - 2 + j) * PST + C_CX + c8) : (u32x4){0u, 0u, 0u, 0u};
                bw[q] = *(const u32x4*)(P + (size_t)row * PST + C_CB + c8); } }
#pragma unroll
        for (int q = 0; q < 4; ++q) { const int idx = idx0 + q * stride; const int row = idx >> 7;
            if (idx < M * 128) { float acc[8];
#pragma unroll
                for (int e = 0; e < 8; ++e) acc[e] = 0.f;
#pragma unroll
                for (int j = 0; j < 3; ++j) { float xv[8]; cv8f(pv[q][j], xv);
#pragma unroll
                    for (int e = 0; e < 4; ++e) { acc[e] += wt[j][0][e] * xv[e]; acc[4 + e] += wt[j][1][e] * xv[4 + e]; } }
                float bv[8]; cv8f(bw[q], bv);
                u32x4 w; w.x = cvt_pk_bf16(bv[0] * acc[0], bv[1] * acc[1]); w.y = cvt_pk_bf16(bv[2] * acc[2], bv[3] * acc[3]); w.z = cvt_pk_bf16(bv[4] * acc[4], bv[5] * acc[5]); w.w = cvt_pk_bf16(bv[6] * acc[6], bv[7] * acc[7]);
                *(u32x4*)(YC + ktm_off(M, row, c8)) = w; } }
    }
}

constexpr int HA_BF = 0, HA_QM = 32768, HA_KM = HA_QM + 64 * 272, HA_KET = HA_KM + 64 * 272, HA_VT = HA_KET + 128 * 144, HA_SEG = HA_VT + 128 * 144, HA_SLR = HA_SEG + 2048, HA_BPV = HA_SLR + 128 * 272, HA_END = HA_BPV + 512;
static_assert(HA_END <= MISC_OFF, "hgrn LDS");
constexpr int HG = 4, NGRP_H = NUNIT_H / HG;
__device__ __forceinline__ void p_hgrn_a(Frame& F, int l) {
    IDS();
    const bf16* P = (const bf16*)(F.ws + WS_P); const float* lbv = (const float*)(F.ws + WS_LBV) + l * 1024;
    bf16* UT = (bf16*)(F.ws + WS_UT); bf16* QB = (bf16*)(F.ws + WS_QB); bf16* OI = (bf16*)(F.ws + WS_OI); float* AV = (float*)(F.ws + WS_AV);
    LAS float* SEG = (LAS float*)(F.lds + HA_SEG); LAS float* BPV = (LAS float*)(F.lds + HA_BPV);
    const int g = LANE >> 4, fr = LANE & 15;
    for (int gi = blockIdx.x; gi < NGRP_H; gi += F.G) {
        const int b = gi >> 6, cg = (gi >> 3) & 7, h = gi & 7, bh = b * 8 + h, grp = bh * 8 + cg;
        const int t = (TID & 15) + 16 * (TID >> 7), d0 = ((TID >> 4) & 7) * 16;
        f32x4 SLv[8];
#pragma unroll
        for (int vb = 0; vb < 8; ++vb) SLv[vb] = (f32x4){0.f, 0.f, 0.f, 0.f};
        if (TID < 128) BPV[TID] = 0.f;
        u32x4 zr[2], qr[2], vr[2];
#define HA_FETCH(jc_) do { const bf16* pf_ = P + (size_t)(b * SEQ + (cg * HG + (jc_)) * 64 + t) * PST + h * 128 + d0; \
            zr[0] = *(const u32x4*)(pf_ + C_HF); zr[1] = *(const u32x4*)(pf_ + C_HF + 8); qr[0] = *(const u32x4*)(pf_ + C_HQ); qr[1] = *(const u32x4*)(pf_ + C_HQ + 8); \
            vr[0] = *(const u32x4*)(pf_ + C_HI); vr[1] = *(const u32x4*)(pf_ + C_HI + 8); } while (0)
        HA_FETCH(0);
        for (int jc = 0; jc < HG; ++jc) {
        const int c = cg * HG + jc, u = bh * 32 + c;
        float q[16], kk[16], bc[16];
        {   float z[16]; cv8f(zr[0], *(float(*)[8])&z[0]); cv8f(zr[1], *(float(*)[8])&z[8]); cv8f(qr[0], *(float(*)[8])&q[0]); cv8f(qr[1], *(float(*)[8])&q[8]);
#pragma unroll
            for (int i = 0; i < 16; i += 4) { const f32x4 lb4 = *(const f32x4*)(lbv + h * 128 + d0 + i);
#pragma unroll
                for (int j = 0; j < 4; ++j) { const float zz = fminf(fmaxf(z[i + j], -80.f), 80.f), e = fast_exp(-zz), sg = 1.0f / (1.0f + e), lb = lb4[j];
                    const float f = lb + (1.0f - lb) * sg; kk[i + j] = (1.0f - lb) * e * sg; bc[i + j] = __builtin_amdgcn_logf(fmaxf(f, 1e-30f)) * 0.69314718056f; } } }
        const int seg = TID >> 7;
#pragma unroll
        for (int i = 0; i < 16; ++i) { float v = bc[i];
            v += __int_as_float(__builtin_amdgcn_update_dpp(0, __float_as_int(v), 0x111, 0xf, 0xf, true));
            v += __int_as_float(__builtin_amdgcn_update_dpp(0, __float_as_int(v), 0x112, 0xf, 0xf, true));
            v += __int_as_float(__builtin_amdgcn_update_dpp(0, __float_as_int(v), 0x114, 0xf, 0xf, true));
            v += __int_as_float(__builtin_amdgcn_update_dpp(0, __float_as_int(v), 0x118, 0xf, 0xf, true));
            bc[i] = v; }
        if ((TID & 15) == 15) {
#pragma unroll
            for (int i = 0; i < 16; i += 4) *(LAS f32x4*)(SEG + seg * 128 + d0 + i) = (f32x4){bc[i], bc[i + 1], bc[i + 2], bc[i + 3]}; }
        __syncthreads();
        {   float vv[16]; cv8f(vr[0], *(float(*)[8])&vv[0]); cv8f(vr[1], *(float(*)[8])&vv[8]);
            unsigned qm[8], km[8], qb[8];
#pragma unroll
            for (int i = 0; i < 16; i += 4) { const f32x4 s0 = *(const LAS f32x4*)(SEG + d0 + i), s1 = *(const LAS f32x4*)(SEG + 128 + d0 + i), s2 = *(const LAS f32x4*)(SEG + 256 + d0 + i), s3 = *(const LAS f32x4*)(SEG + 384 + d0 + i);
                const f32x4 r4 = s0 + s1, l4 = r4 + (s2 + s3), zero4 = (f32x4){0.f, 0.f, 0.f, 0.f}, off4 = seg == 0 ? zero4 : seg == 1 ? s0 : seg == 2 ? r4 : r4 + s2;
                const f32x4 b4 = (f32x4){bc[i], bc[i + 1], bc[i + 2], bc[i + 3]} + off4, bp4 = *(const LAS f32x4*)(BPV + d0 + i);
                float qmv[4], kmv[4], qbv[4];
#pragma unroll
                for (int j = 0; j < 4; ++j) { const float bb = b4[j], rr = r4[j]; qmv[j] = q[i + j] * fast_exp(fminf(bb - rr, 80.f)); kmv[j] = kk[i + j] * fast_exp(fminf(rr - bb, 80.f)); qbv[j] = q[i + j] * fast_exp(bb + bp4[j]);
                    const float ke = kk[i + j] * fast_exp(l4[j] - bb);
                    *(LAS bf16*)(F.lds + HA_KET + (d0 + i + j) * 144 + t * 2) = (bf16)(cvt_pk_bf16(ke, 0.f) & 0xffffu);
                    *(LAS bf16*)(F.lds + HA_VT + (d0 + i + j) * 144 + t * 2) = (bf16)(cvt_pk_bf16(vv[i + j], 0.f) & 0xffffu); }
                qm[i / 2] = cvt_pk_bf16(qmv[0], qmv[1]); qm[i / 2 + 1] = cvt_pk_bf16(qmv[2], qmv[3]); km[i / 2] = cvt_pk_bf16(kmv[0], kmv[1]); km[i / 2 + 1] = cvt_pk_bf16(kmv[2], kmv[3]);
                qb[i / 2] = cvt_pk_bf16(qbv[0], qbv[1]); qb[i / 2 + 1] = cvt_pk_bf16(qbv[2], qbv[3]); }
            *(LAS u32x4*)(F.lds + HA_QM + t * 272 + d0 * 2) = (u32x4){qm[0], qm[1], qm[2], qm[3]}; *(LAS u32x4*)(F.lds + HA_QM + t * 272 + d0 * 2 + 16) = (u32x4){qm[4], qm[5], qm[6], qm[7]};
            *(LAS u32x4*)(F.lds + HA_KM + t * 272 + d0 * 2) = (u32x4){km[0], km[1], km[2], km[3]}; *(LAS u32x4*)(F.lds + HA_KM + t * 272 + d0 * 2 + 16) = (u32x4){km[4], km[5], km[6], km[7]};
            bf16* qg = QB + ((size_t)u * 64 + t) * 128 + d0;
            *(u32x4*)qg = (u32x4){qb[0], qb[1], qb[2], qb[3]}; *(u32x4*)(qg + 8) = (u32x4){qb[4], qb[5], qb[6], qb[7]};
            if (jc > 0) {
                const f32x4 rw = *(const LAS f32x4*)(SEG + 16 * WAVE + 4 * g) + *(const LAS f32x4*)(SEG + 128 + 16 * WAVE + 4 * g); const f32x4 er = (f32x4){fast_exp(rw[0]), fast_exp(rw[1]), fast_exp(rw[2]), fast_exp(rw[3])};
#pragma unroll
                for (int vb = 0; vb < 8; ++vb) { const f32x4 sv = SLv[vb] * er; u32x2 w; w.x = cvt_pk_bf16(sv[0], sv[1]); w.y = cvt_pk_bf16(sv[2], sv[3]);
                    *(LAS u32x2*)(F.lds + HA_SLR + (16 * vb + fr) * 272 + (16 * WAVE + 4 * g) * 2) = w; } }
        }
        __syncthreads();
        if (TID < 128) BPV[TID] += (SEG[TID] + SEG[128 + TID]) + (SEG[256 + TID] + SEG[384 + TID]);
        if (jc + 1 < HG) HA_FETCH(jc + 1);
        {   bf16x8 ka[2];
#pragma unroll
            for (int i = 0; i < 2; ++i) ka[i] = *(const LAS bf16x8*)(F.lds + HA_KET + (16 * WAVE + fr) * 144 + (32 * i + 8 * g) * 2);
            const f32x4 lw = (*(const LAS f32x4*)(SEG + 16 * WAVE + 4 * g) + *(const LAS f32x4*)(SEG + 128 + 16 * WAVE + 4 * g)) + (*(const LAS f32x4*)(SEG + 256 + 16 * WAVE + 4 * g) + *(const LAS f32x4*)(SEG + 384 + 16 * WAVE + 4 * g)); const f32x4 a4 = (f32x4){fast_exp(lw[0]), fast_exp(lw[1]), fast_exp(lw[2]), fast_exp(lw[3])};
#pragma unroll
            for (int vb = 0; vb < 8; ++vb) { f32x4 o = (f32x4){0.f, 0.f, 0.f, 0.f};
#pragma unroll
                for (int i = 0; i < 2; ++i) { const bf16x8 vbq = *(const LAS bf16x8*)(F.lds + HA_VT + (16 * vb + fr) * 144 + (32 * i + 8 * g) * 2); o = __builtin_amdgcn_mfma_f32_16x16x32_bf16(ka[i], vbq, o, 0, 0, 0); }
                SLv[vb] = a4 * SLv[vb] + o; } }
        {   const int tb = WAVE & 3, vh = WAVE >> 2;
            bf16x8 qfr[4];
#pragma unroll
            for (int i = 0; i < 4; ++i) qfr[i] = *(const LAS bf16x8*)(F.lds + HA_QM + (16 * tb + fr) * 272 + (32 * i + 8 * g) * 2);
            f32x4 sc[4];
#pragma unroll
            for (int sb = 0; sb < 4; ++sb) { sc[sb] = (f32x4){0.f, 0.f, 0.f, 0.f};
                if (sb <= tb) {
#pragma unroll
                    for (int i = 0; i < 4; ++i) { const bf16x8 ka = *(const LAS bf16x8*)(F.lds + HA_KM + (16 * sb + fr) * 272 + (32 * i + 8 * g) * 2); sc[sb] = __builtin_amdgcn_mfma_f32_16x16x32_bf16(ka, qfr[i], sc[sb], 0, 0, 0); }
                    if (sb == tb) {
#pragma unroll
                        for (int r = 0; r < 4; ++r) if (4 * g + r > fr) sc[sb][r] = 0.f; } } }
            bf16x8 pf[2];
#pragma unroll
            for (int i = 0; i < 2; ++i) { u32x4 w; w.x = cvt_pk_bf16(sc[2 * i][0], sc[2 * i][1]); w.y = cvt_pk_bf16(sc[2 * i][2], sc[2 * i][3]); w.z = cvt_pk_bf16(sc[2 * i + 1][0], sc[2 * i + 1][1]); w.w = cvt_pk_bf16(sc[2 * i + 1][2], sc[2 * i + 1][3]); pf[i] = __builtin_bit_cast(bf16x8, w); }
#pragma unroll
            for (int vq = 0; vq < 4; ++vq) { const int vb = vh * 4 + vq; f32x4 o = (f32x4){0.f, 0.f, 0.f, 0.f};
#pragma unroll
                for (int i = 0; i < 2; ++i) { const LAS unsigned char* vp = F.lds + HA_VT + (16 * vb + fr) * 144 + (32 * i + 4 * g) * 2;
                    const u32x2 lo = *(const LAS u32x2*)vp, hi = *(const LAS u32x2*)(vp + 32); u32x4 w; w.x = lo.x; w.y = lo.y; w.z = hi.x; w.w = hi.y;
                    o = __builtin_amdgcn_mfma_f32_16x16x32_bf16(__builtin_bit_cast(bf16x8, w), pf[i], o, 0, 0, 0); }
                if (jc > 0) {
#pragma unroll
                    for (int i = 0; i < 4; ++i) { const bf16x8 sa = *(const LAS bf16x8*)(F.lds + HA_SLR + (16 * vb + fr) * 272 + (32 * i + 8 * g) * 2); o = __builtin_amdgcn_mfma_f32_16x16x32_bf16(sa, qfr[i], o, 0, 0, 0); } }
                u32x2 w; w.x = cvt_pk_bf16(o[0], o[1]); w.y = cvt_pk_bf16(o[2], o[3]);
                *(u32x2*)(OI + ((size_t)u * 64 + 16 * tb + fr) * 128 + 16 * vb + 4 * g) = w; } }
        __syncthreads();
        }
#pragma unroll
        for (int vb = 0; vb < 8; ++vb) { u32x2 w; w.x = cvt_pk_bf16(SLv[vb][0], SLv[vb][1]); w.y = cvt_pk_bf16(SLv[vb][2], SLv[vb][3]);
            *(u32x2*)(UT + ((size_t)grp * 128 + 16 * vb + fr) * 128 + 16 * WAVE + 4 * g) = w; }
        if (TID < 128) AV[(size_t)grp * 128 + TID] = fast_exp(BPV[TID]);
        __syncthreads();
#undef HA_FETCH
    }
}
constexpr int HC_AV_OFF = 40960;
constexpr int HC_STRIDE = 272;
__device__ __forceinline__ void p_hgrn_c(Frame& F, int l) {
    IDS();
    const bf16* P = (const bf16*)(F.ws + WS_P); const bf16* UT = (const bf16*)(F.ws + WS_UT); const float* AV = (const float*)(F.ws + WS_AV); const bf16* QB = (const bf16*)(F.ws + WS_QB); const bf16* OI = (const bf16*)(F.ws + WS_OI);
    bf16* YC = (bf16*)(F.ws + WS_YCAT); const float* ng = F.in[10] + l * 128;
    const int g = LANE >> 4, fr = LANE & 15;
    for (int gi = blockIdx.x; gi < NGRP_H; gi += F.G) {
        const int b = gi >> 6, cg = (gi >> 3) & 7, h = gi & 7, bh = b * 8 + h;
        {   const int v = TID >> 2, dq = (TID & 3) * 32;
            float st[32];
#pragma unroll
            for (int i = 0; i < 32; ++i) st[i] = 0.f;
            LAS float* AVL = (LAS float*)(F.lds + HC_AV_OFF);
            for (int idx = TID; idx < cg * 128; idx += NWAVES * 64) AVL[idx] = AV[(size_t)(bh * (32 / HG)) * 128 + idx];
            u32x4 uw[7][4];
#pragma unroll
            for (int j = 0; j < 7; ++j) if (j < cg) {
#pragma unroll
                for (int i = 0; i < 4; ++i) uw[j][i] = *(const u32x4*)(UT + ((size_t)(bh * (32 / HG) + j) * 128 + v) * 128 + dq + 8 * i); }
            __syncthreads();
#pragma unroll
            for (int j = 0; j < 7; ++j) if (j < cg) { f32x4 aw[8];
#pragma unroll
                for (int i = 0; i < 8; ++i) aw[i] = *(const LAS f32x4*)(AVL + j * 128 + dq + 4 * i);
#pragma unroll
                for (int i = 0; i < 4; ++i) { const unsigned ww[4] = {uw[j][i].x, uw[j][i].y, uw[j][i].z, uw[j][i].w};
#pragma unroll
                    for (int k = 0; k < 4; ++k) { const int e = 8 * i + 2 * k; st[e] = aw[e >> 2][e & 3] * st[e] + bflo(ww[k]); st[e + 1] = aw[(e + 1) >> 2][(e + 1) & 3] * st[e + 1] + bfhi(ww[k]); } } }
#pragma unroll
            for (int i = 0; i < 4; ++i) { u32x4 w; w.x = cvt_pk_bf16(st[8 * i], st[8 * i + 1]); w.y = cvt_pk_bf16(st[8 * i + 2], st[8 * i + 3]); w.z = cvt_pk_bf16(st[8 * i + 4], st[8 * i + 5]); w.w = cvt_pk_bf16(st[8 * i + 6], st[8 * i + 7]);
                *(LAS u32x4*)(F.lds + v * HC_STRIDE + (dq + 8 * i) * 2) = w; } }
        __syncthreads();
#pragma unroll 1
        for (int r2 = 0; r2 < 2; ++r2) {
        const int tk = WAVE * 2 + r2, jc = tk >> 2, tb = tk & 3, c = cg * HG + jc, u = bh * 32 + c;
        f32x4 o[8];
#pragma unroll
        for (int vb = 0; vb < 8; ++vb) { const u32x2 w = *(const u32x2*)(OI + ((size_t)u * 64 + 16 * tb + fr) * 128 + 16 * vb + 4 * g); o[vb] = (f32x4){bflo(w.x), bfhi(w.x), bflo(w.y), bfhi(w.y)}; }
        bf16x8 bq[4];
#pragma unroll
        for (int i = 0; i < 4; ++i) bq[i] = *(const bf16x8*)(QB + ((size_t)u * 64 + 16 * tb + fr) * 128 + 32 * i + 8 * g);
        if (cg > 0) {
#pragma unroll
            for (int i = 0; i < 4; ++i)
#pragma unroll
                for (int vb = 0; vb < 8; ++vb) { const bf16x8 a = *(const LAS bf16x8*)(F.lds + (16 * vb + fr) * HC_STRIDE + (32 * i + 8 * g) * 2); o[vb] = __builtin_amdgcn_mfma_f32_16x16x32_bf16(a, bq[i], o[vb], 0, 0, 0); } }
        float ss = 0.f;
#pragma unroll
        for (int vb = 0; vb < 8; ++vb) ss += (o[vb][0] * o[vb][0] + o[vb][1] * o[vb][1]) + (o[vb][2] * o[vb][2] + o[vb][3] * o[vb][3]);
        ss += __shfl_xor(ss, 16); ss += __shfl_xor(ss, 32);
        const float rs = rsqrtf(ss * (1.0f / 128.0f) + EPS);
        const int row = b * SEQ + c * 64 + 16 * tb + fr;
#pragma unroll
        for (int vb = 0; vb < 8; ++vb) { const int v0 = 16 * vb + 4 * g; const f32x4 n4 = *(const f32x4*)(ng + v0); const u32x2 gw2 = *(const u32x2*)(P + (size_t)row * PST + C_HG + h * 128 + v0);
            const float g0 = bflo(gw2.x), g1 = bfhi(gw2.x), g2 = bflo(gw2.y), g3 = bfhi(gw2.y);
            const float y0 = o[vb][0] * rs * n4[0] * g0 * fast_rcp(1.0f + fast_exp(-g0)), y1 = o[vb][1] * rs * n4[1] * g1 * fast_rcp(1.0f + fast_exp(-g1));
            const float y2 = o[vb][2] * rs * n4[2] * g2 * fast_rcp(1.0f + fast_exp(-g2)), y3 = o[vb][3] * rs * n4[3] * g3 * fast_rcp(1.0f + fast_exp(-g3));
            u32x2 w; w.x = cvt_pk_bf16(y0, y1); w.y = cvt_pk_bf16(y2, y3); *(u32x2*)(YC + ktm_off(M, row, NBW + h * 128 + v0)) = w; }
        }
        __syncthreads();
    }
}
__device__ __forceinline__ void p_final(Frame& F) {
    IDS();
    const int gw = F.vcu * NWAVES + WAVE, NGW = F.G * NWAVES; const float* fn = F.in[19];
    for (int row = gw; row < M; row += NGW) { float* xr = F.out + (size_t)row * D;
        f32x4 v[8]; float s = 0.f;
#pragma unroll
        for (int j = 0; j < 8; ++j) { v[j] = *(const f32x4*)(xr + 4 * LANE + 256 * j); s += (v[j][0] * v[j][0] + v[j][1] * v[j][1]) + (v[j][2] * v[j][2] + v[j][3] * v[j][3]); }
        s = wave_sum(s); const float rs = rsqrtf(s * (1.0f / D) + EPS);
#pragma unroll
        for (int j = 0; j < 8; ++j) { const f32x4 gn = *(const f32x4*)(fn + 4 * LANE + 256 * j); *(f32x4*)(xr + 4 * LANE + 256 * j) = v[j] * rs * gn; }
    }
}

constexpr int PH_PRO = 0, PH_L0 = 1, PH_FINAL = 37, NPH = 38;
__global__ void __launch_bounds__(NWAVES * 64, 2) fwd(Args args) {
    __shared__ __attribute__((aligned(16))) unsigned char lds_raw[LDS_BYTES];
    Frame F;
    F.lds = (LAS unsigned char*)lds_raw;
    F.G = gridDim.x; { const int bx = blockIdx.x; F.vcu = (F.G % 8 == 0) ? (bx % 8) * (F.G / 8) + bx / 8 : bx; }
    F.in = args.in; F.out = args.out; F.ws = args.ws;
    const int lo = args.ph_lo, hi = args.ph_hi;
    volatile LAS unsigned* MISC = (volatile LAS unsigned*)(F.lds + MISC_OFF);
    for (int u = threadIdx.x; u < 128; u += NWAVES * 64) MISC[u] = 0u;
    __syncthreads();
    XcdBarrier bar; bar.bar = (unsigned*)(F.ws + WS_CTL + CTL_BAR_OFF); bar.x = 0; bar.st = MISC + 8;
    if (hi - lo > 1) bar = xcd_barrier_post((unsigned*)(F.ws + WS_CTL + CTL_BAR_OFF), MISC + 8);
#define IN(k) (lo <= (k) && (k) < hi)
#define SEAM(k) do { if (IN(k) && IN((k) + 1)) xcd_barrier(bar); } while (0)
    float* ssq = (float*)(F.ws + WS_SSQ);
    const bool fuse_final = !MK_PER_PHASE && F.G == (M / 256) * (D / 256);
    bf16* XB = (bf16*)(F.ws + WS_XB); bf16* HMID = (bf16*)(F.ws + WS_HMID); bf16* PB = (bf16*)(F.ws + WS_P); bf16* YC = (bf16*)(F.ws + WS_YCAT); bf16* MG = (bf16*)(F.ws + WS_MERGED);

    if (IN(PH_PRO)) { p_prologue(F, 0, DEPTH, true); }
    SEAM(PH_PRO);
    int ph = PH_L0;
    for (int sl = 0; sl < 3 * DEPTH; ++sl) {
        const int l = sl / 3, kind = sl - 3 * l;
        if (kind != 1) {
            const bool second = kind == 2;
            if (IN(ph)) {
                pg8::Gemm g{XB, wl_ptr(F.ws, l, second ? WL_GU2 : WL_GU1), M, 2 * FF, D / 64}; pg8::TileOrder<1> S; S.init(M, 2 * FF, F.G, (int)blockIdx.x);
                pg8::EpiSwiglu E{HMID, FF, ssq + (size_t)sl * M * 32};
                { pg8::Unit u0; if (S.next(0, u0)) { pg8::fill_rstd_table((LAS float*)(F.lds + pg8::RSTD_LDS_OFF), E.ssq, u0.pm); E.tab = (const LAS float*)(F.lds + pg8::RSTD_LDS_OFF); E.tab_pm = u0.pm; } }
                pg8::gemm_phase<pg8::EpiSwiglu, pg8::TileOrder<1>, true>(F.lds, g, S, E);
                if (sl == 0) {
                    const int cb = (int)blockIdx.x - (int)(F.G / 2), Gh = F.G - F.G / 2, ck = cb >= 0 ? cb : (1 << 20), cv = cb >= 0 ? (cb + Gh / 2) % Gh : (1 << 20);
                    {   pg8::Gemm g2{(const bf16*)(F.ws + WS_MEMB), (const bf16*)(F.ws + WS_WK), MEMR, 4096, D / 64}; pg8::TileOrder<1> S2; S2.init(MEMR, 4096, Gh, ck);
                        pg8::EpiBf16Rs E2{(bf16*)(F.ws + WS_KB), 4096, nullptr, nullptr, 1 << 30};
                        pg8::gemm_phase<pg8::EpiBf16Rs, pg8::TileOrder<1>, true>(F.lds, g2, S2, E2); }
                    {   pg8::Gemm g2{(const bf16*)(F.ws + WS_WV), (const bf16*)(F.ws + WS_MEMBP), 4096, MEMR, D / 64}; pg8::TileOrder<1> S2; S2.init(4096, MEMR, Gh, cv);
                        pg8::EpiBf16Rs E2{(bf16*)(F.ws + WS_VT), MEMR, nullptr, nullptr, 1 << 30};
                        pg8::gemm_phase<pg8::EpiBf16Rs, pg8::TileOrder<1>, true>(F.lds, g2, S2, E2); } }
                if (LAZY_D2) { if (second && l + 1 < DEPTH) p_convert_d2(F, l + 1, 0); if (!second && l >= 1) p_convert_d2(F, l, 1); } }
            SEAM(ph);
            if (IN(ph + 1)) {
                pg8::Gemm g{HMID, wl_ptr(F.ws, l, second ? WL_D2 : WL_D1), M, D, FF / 64}; pg8::TileOrder<1> S; S.init(M, D, F.G, (int)blockIdx.x);
                if (sl == 3 * DEPTH - 1 && fuse_final) {
                    pg8::EpiResidFin E{XB, F.out, ssq + (size_t)(sl + 1) * M * 32, 0.5f, F.in[19], (unsigned*)(F.ws + WS_CTL + CTL_BAR_OFF), (unsigned*)(F.ws + WS_CTL + CTL_PANEL_OFF)};
                    pg8::gemm_phase<pg8::EpiResidFin, pg8::TileOrder<1>, true>(F.lds, g, S, E);
                } else {
                    pg8::EpiResid E{XB, ssq + (size_t)(sl + 1) * M * 32, 0.5f, (sl == 3 * DEPTH - 1) ? F.out : nullptr};
                    pg8::gemm_phase<pg8::EpiResid, pg8::TileOrder<1>, false>(F.lds, g, S, E); } }
            if (!(sl == 3 * DEPTH - 1 && fuse_final)) SEAM(ph + 1);
            ph += 2;
        } else {
            if (IN(ph)) {
                pg8::Gemm g{XB, wl_ptr(F.ws, l, WL_IN), M, INC, D / 64}; pg8::TileOrder<1> S; S.init(M, INC, F.G, (int)blockIdx.x);
                pg8::EpiBf16Rs E{PB, PST, ssq + (size_t)sl * M * 32, (bf16*)(F.ws + WS_GF), PST / 256};
                E.NT = true; E.prod_pn = 8;
                { pg8::Unit u0; if (S.next(0, u0)) { pg8::fill_rstd_table((LAS float*)(F.lds + pg8::RSTD_LDS_OFF), E.ssq, u0.pm); E.tab = (const LAS float*)(F.lds + pg8::RSTD_LDS_OFF); E.tab_pm = u0.pm; } }
                pg8::gemm_phase<pg8::EpiBf16Rs, pg8::TileOrder<1>, true>(F.lds, g, S, E); }
            SEAM(ph);
            if (IN(ph + 1)) {
                const bool cf = (blockIdx.x >> 3) & 1;
                if (cf) p_conv(F, l);
                if ((blockIdx.x >> 4) & 1) { p_attn(F, l); p_hgrn_a(F, l); } else { p_hgrn_a(F, l); p_attn(F, l); }
                if (!cf) p_conv(F, l); }
            SEAM(ph + 1);
            if (IN(ph + 2)) { p_hgrn_c(F, l); }
            SEAM(ph + 2);
            if (IN(ph + 3)) {
                pg8::Gemm g{YC, wl_ptr(F.ws, l, WL_BR), M, D, NBW / 64}; pg8::TileOrder<3> S; S.init(M, D, F.G, (int)blockIdx.x);
                pg8::EpiBranch E{MG, (const bf16*)(F.ws + WS_GF)};
                pg8::gemm_phase<pg8::EpiBranch, pg8::TileOrder<3>, false>(F.lds, g, S, E); }
            SEAM(ph + 3);
            if (IN(ph + 4)) {
                pg8::Gemm g{MG, wl_ptr(F.ws, l, WL_O), M, D, D / 64}; pg8::TileOrder<1> S; S.init(M, D, F.G, (int)blockIdx.x);
                pg8::EpiResid E{XB, ssq + (size_t)(sl + 1) * M * 32, 1.0f, nullptr};
                pg8::gemm_phase<pg8::EpiResid, pg8::TileOrder<1>, false>(F.lds, g, S, E); }
            SEAM(ph + 4);
            ph += 5;
        }
    }
    if (IN(PH_FINAL) && !fuse_final) { p_final(F); }
#undef IN
#undef SEAM
}

extern "C" void kernel_launch(void* const* d_in, const int* in_sizes, int n_in, void* d_out, int out_size, void* d_ws, size_t ws_size, hipStream_t stream) {
    static int grid = 0;
    if (grid == 0) {
        if (n_in != 20 || in_sizes[0] != M * D || out_size != M * D || ws_size < WS_END) { fprintf(stderr, "kernel_launch: unexpected shapes (n_in %d, in0 %d, out %d, ws %zu < %zu); nothing launched\n", n_in, n_in > 0 ? in_sizes[0] : -1, out_size, ws_size, (size_t)WS_END); grid = -1; return; }
        int dev = 0, cus = 0, per_cu = 0;
        if (hipGetDevice(&dev) != hipSuccess || hipDeviceGetAttribute(&cus, hipDeviceAttributeMultiprocessorCount, dev) != hipSuccess) { grid = -1; return; }
        if (hipOccupancyMaxActiveBlocksPerMultiprocessor(&per_cu, (const void*)fwd, NWAVES * 64, 0) != hipSuccess || per_cu < 1) fprintf(stderr, "kernel_launch: occupancy query reports %d\n", per_cu);
        (void)hipGetLastError();
        grid = cus;
    }
    if (grid < 0) return;
    if (hipMemsetAsync((char*)d_ws + WS_CTL, 0, CTL_ZERO_BYTES, stream) != hipSuccess) return;
    Args a{};
    for (int i = 0; i < 20; ++i) a.in[i] = (const float*)d_in[i];
    a.out = (float*)d_out; a.ws = (unsigned char*)d_ws;
#if MK_PER_PHASE
    for (int p = 0; p < NPH; ++p) { a.ph_lo = p; a.ph_hi = p + 1; hipLaunchKernelGGL(fwd, dim3(grid), dim3(NWAVES * 64), 0, stream, a); }
#else
    a.ph_lo = 0; a.ph_hi = NPH; hipLaunchKernelGGL(fwd, dim3(grid), dim3(NWAVES * 64), 0, stream, a);
#endif
}
```

```cpp
#include <hip/hip_runtime.h>
#include <cstdio>
#include <cstdint>

#ifndef MK_PER_PHASE
#define MK_PER_PHASE 0
#endif
#ifndef LAZY_D2
#define LAZY_D2 1
#endif

#define LAS __attribute__((address_space(3)))
#define GAS __attribute__((address_space(1)))
typedef unsigned short bf16;
typedef short bf16x8 __attribute__((ext_vector_type(8)));
typedef float f32x4 __attribute__((ext_vector_type(4)));
typedef float f32x2 __attribute__((ext_vector_type(2)));
typedef unsigned u32x4 __attribute__((ext_vector_type(4)));
typedef unsigned u32x2 __attribute__((ext_vector_type(2)));

constexpr int D = 2048, BATCH = 4, SEQ = 2048, DEPTH = 4, M = BATCH * SEQ, MEML = 256, MEMR = BATCH * MEML;
constexpr int FF = 5632, INC = 14336, NBW = 1024, PST = 8192;
constexpr int C_CX = 0, C_CB = 2048, C_HQ = 3072, C_HF = 4096, C_HI = 5120, C_HG = 6144, C_AQ = 7168, C_GATE = 8192;
constexpr float EPS = 1e-6f;
constexpr int NUNIT_H = BATCH * 8 * 32;

constexpr size_t MiB = 1u << 20;
constexpr size_t WS_CTL = 0, CTL_ZERO_BYTES = 16384;
constexpr size_t CTL_BAR_OFF = 0, CTL_PANEL_OFF = 14080;
constexpr size_t WS_LBV = 2 * MiB;
constexpr size_t WS_WL = 3 * MiB;
constexpr size_t WL_GU1 = 0, WL_D1 = 44 * MiB, WL_IN = 66 * MiB, WL_BR = 122 * MiB, WL_O = 134 * MiB, WL_GU2 = 142 * MiB, WL_D2 = 186 * MiB, WL_SIZE = 208 * MiB;
constexpr size_t WS_WK = WS_WL + 4 * WL_SIZE;
constexpr size_t WS_WV = WS_WK + 16 * MiB;
constexpr size_t WS_MEMB = WS_WV + 16 * MiB;
constexpr size_t WS_MEMBP = WS_MEMB + 4 * MiB;
constexpr size_t WS_KB = WS_MEMBP + 4 * MiB;
constexpr size_t WS_VT = WS_KB + 8 * MiB;
constexpr size_t WS_XB = WS_VT + 8 * MiB;
constexpr size_t WS_P = WS_XB + 32 * MiB;
constexpr size_t WS_GF = WS_P + 128 * MiB;
constexpr size_t WS_YCAT = WS_GF + 96 * MiB;
constexpr size_t WS_SCR = WS_YCAT + 48 * MiB;
constexpr size_t WS_HMID = WS_SCR;
constexpr size_t WS_UT = WS_SCR;
constexpr size_t WS_ST = WS_UT + 32 * MiB;
constexpr size_t WS_QB = WS_ST + 32 * MiB;
constexpr size_t WS_OI = WS_QB + 16 * MiB;
constexpr size_t WS_AV = WS_OI + 16 * MiB;
constexpr size_t WS_MERGED = WS_SCR;
constexpr size_t WS_SSQ = WS_SCR + 97 * MiB;
constexpr size_t WS_END = WS_SSQ + 13 * MiB;

constexpr int LDS_BYTES = 147456;
constexpr int MISC_OFF = LDS_BYTES - 512;
constexpr int NWAVES = 8;

#define RLX_AGENT __ATOMIC_RELAXED, __HIP_MEMORY_SCOPE_AGENT
#define LDS_WAIT() asm volatile("s_waitcnt lgkmcnt(0)" ::: "memory")
#define VM_WAIT() asm volatile("s_waitcnt vmcnt(0)" ::: "memory")

typedef __bf16 bf16x2_t __attribute__((ext_vector_type(2)));
__device__ __forceinline__ unsigned cvt_pk_bf16(float lo, float hi) { const f32x2 v = {lo, hi}; const bf16x2_t b = __builtin_convertvector(v, bf16x2_t); return __builtin_bit_cast(unsigned, b); }
__device__ __forceinline__ float bflo(unsigned w) { return __uint_as_float(w << 16); }
__device__ __forceinline__ float bfhi(unsigned w) { return __uint_as_float(w & 0xffff0000u); }
__device__ __forceinline__ float fast_exp(float x) { return __builtin_amdgcn_exp2f(x * 1.44269504089f); }
__device__ __forceinline__ float fast_rcp(float x) { return __builtin_amdgcn_rcpf(x); }
__device__ __forceinline__ float wave_sum(float v) {
#pragma unroll
    for (int o = 1; o < 64; o <<= 1) v += __shfl_xor(v, o);
    return v;
}

__device__ __forceinline__ size_t ktm_off(int R, int r, int k) {
    const int rl = r & 127, c = k & 63, st = (rl >> 4) * 2 + (c >> 5), ob = (rl & 15) * 64 + (c & 31) * 2;
    return ((size_t)(k >> 6) * R + (r & ~127)) * 64 + ((st * 1024 + (ob ^ (((ob >> 9) & 1) << 5))) >> 1);
}
__device__ __forceinline__ int perm_slot(int n) { return (n & ~31) | (16 * ((n >> 2) & 1) + 4 * ((n >> 3) & 3) + (n & 3)); }

namespace pg8 {
constexpr int BM = 256, BK = 64, HALF = 128, HTB = HALF * BK * 2, STAGE_BYTES = 8 * HTB, NXCD = 8, WGM = 8;
__host__ __device__ __forceinline__ int lds_byte(int r, int c) { const int st = (r >> 4) * 2 + (c >> 5), rr = r & 15, cc = c & 31, ob = rr * 64 + cc * 2; return st * 1024 + (ob ^ (((ob >> 9) & 1) << 5)); }
__host__ __device__ __forceinline__ void stage_rc(int b, int& R, int& C) { const int st = b / 1024, sb = b % 1024, swz = sb ^ (((sb >> 9) & 1) << 5); R = (st >> 1) * 16 + swz / 64; C = (st & 1) * 32 + (swz % 64) / 2; }
__host__ __device__ __forceinline__ int perm32(int rho) { const int n = rho >> 4, i = rho & 15; return 8 * (i >> 2) + 4 * n + (i & 3); }

struct Unit { int pm, pn, sub; };
struct Gemm { const bf16* A; const bf16* Bt; int ra, rb, nt; };

template <int NSUB> struct TileOrder {
    int nM, nN, nwg, G, c;
    __device__ __forceinline__ void init(int Mr, int Nc, int G_, int c_) { nM = Mr / BM; nN = Nc / BM; nwg = nM * nN; G = G_; c = c_; }
    __device__ __forceinline__ bool next(int i, Unit& u) const {
        const int ti = i / NSUB; u.sub = i - ti * NSUB;
        const long L = (long)ti * G + c; if (L >= nwg) return false;
        int wgid = (int)L; { const int q = nwg / NXCD, r = nwg % NXCD, xcd = wgid % NXCD, off = wgid / NXCD; wgid = (xcd < r ? xcd * (q + 1) : r * (q + 1) + (xcd - r) * q) + off; }
        const int nig = WGM * nN, gid = wgid / nig, fm = gid * WGM, gsz = (nM - fm) < WGM ? (nM - fm) : WGM;
        u.pm = fm + ((wgid % nig) % gsz); u.pn = (wgid % nig) / gsz; return true;
    }
};

__device__ __forceinline__ void ssq_load(const float* ssq, int row, int fq, f32x4& a, f32x4& b) { const float* p = ssq + (size_t)row * 32 + fq * 8; a = *(const f32x4*)p; b = *(const f32x4*)(p + 4); }
__device__ __forceinline__ float ssq_rstd(const f32x4& a, const f32x4& b) { float s = ((a[0] + a[1]) + (a[2] + a[3])) + ((b[0] + b[1]) + (b[2] + b[3])); s += __shfl_xor(s, 16); s += __shfl_xor(s, 32); return rsqrtf(s * (1.0f / D) + EPS); }

__device__ __forceinline__ size_t gf_off(int pm, int n, int pn, int wid, int k16, int lane) { return ((((((size_t)pm * 3 + n) * 8 + pn) * 8 + wid) * 16 + k16) * 64 + lane) * 8; }
constexpr int RSTD_LDS_OFF = 131072;
__device__ __forceinline__ void rstd8(const float* ssq, const LAS float* tab, int tab_pm, const Unit& u, int wr, int fr, int fq, float (&rsv)[8]) {
    if (u.pm == tab_pm) {
#pragma unroll
        for (int i = 0; i < 8; ++i) rsv[i] = tab[(i >> 2) * HALF + wr * 64 + (i & 3) * 16 + fr];
    } else { const int row0 = u.pm * BM + wr * 64 + fr;
#pragma unroll
        for (int hb = 0; hb < 2; ++hb) { f32x4 pa[4], pb[4];
#pragma unroll
            for (int i = 0; i < 4; ++i) ssq_load(ssq, row0 + hb * HALF + i * 16, fq, pa[i], pb[i]);
#pragma unroll
            for (int i = 0; i < 4; ++i) rsv[hb * 4 + i] = ssq_rstd(pa[i], pb[i]); } }
}
struct EpiBf16Rs {
    static constexpr bool PERM = true; static constexpr int NSUB = 1;
    __device__ __forceinline__ int nstores(const Unit& u) const { return 8; }
    bf16* O; int ldc; const float* ssq; bf16* GF; int gate_pn0; bool NT = false; const LAS float* tab = nullptr; int tab_pm = -1; int prod_pn = 0;
    __device__ __forceinline__ void operator()(f32x4 (&acc)[2][2][4][2], const Unit& u, int wr, int wc, int fr, int fq) const {
        asm volatile("" : "+v"(fr), "+v"(fq));
        const int row0 = u.pm * BM + wr * 64 + fr, col0 = u.pn * BM + wc * 32 + 8 * fq;
        float rsv[8];
        if (ssq) { rstd8(ssq, tab, tab_pm, u, wr, fr, fq, rsv);
        } else {
#pragma unroll
            for (int i = 0; i < 8; ++i) rsv[i] = 1.0f; }
        if (u.pn < prod_pn) {
            const int colp = u.pn * HALF + wc * 32 + 8 * fq;
#pragma unroll
            for (int ai = 0; ai < 2; ++ai)
#pragma unroll
                for (int m = 0; m < 4; ++m) { const int row = row0 + ai * HALF + m * 16; const float rs2 = rsv[ai * 4 + m] * rsv[ai * 4 + m];
                    const f32x4 p0 = acc[ai][0][m][0] * acc[ai][1][m][0] * rs2, p1 = acc[ai][0][m][1] * acc[ai][1][m][1] * rs2;
                    u32x4 w; w.x = cvt_pk_bf16(p0[0], p0[1]); w.y = cvt_pk_bf16(p0[2], p0[3]); w.z = cvt_pk_bf16(p1[0], p1[1]); w.w = cvt_pk_bf16(p1[2], p1[3]);
                    __builtin_nontemporal_store(w, (u32x4*)(O + (size_t)row * ldc + colp)); }
            return; }
        if (u.pn >= gate_pn0) {
            const int gt = u.pn - gate_pn0; bf16* gp = GF + gf_off(u.pm, gt >> 3, gt & 7, wr * 4 + wc, 0, fq * 16 + fr);
#pragma unroll
            for (int ai = 0; ai < 2; ++ai)
#pragma unroll
                for (int m = 0; m < 4; ++m) { const float rs = rsv[ai * 4 + m];
#pragma unroll
                    for (int bj = 0; bj < 2; ++bj) { float sg[8];
#pragma unroll
                        for (int n = 0; n < 2; ++n)
#pragma unroll
                            for (int j = 0; j < 4; ++j) { const float a = fminf(fmaxf(acc[ai][bj][m][n][j] * rs, -30.f), 30.f); sg[n * 4 + j] = fast_rcp(1.0f + fast_exp(-a)); }
                        u32x4 w; w.x = cvt_pk_bf16(sg[0], sg[1]); w.y = cvt_pk_bf16(sg[2], sg[3]); w.z = cvt_pk_bf16(sg[4], sg[5]); w.w = cvt_pk_bf16(sg[6], sg[7]);
                        __builtin_nontemporal_store(w, (u32x4*)(gp + (size_t)(((ai * 4 + m) * 2 + bj) * 64) * 8)); } }
            return; }
#pragma unroll
        for (int ai = 0; ai < 2; ++ai)
#pragma unroll
            for (int m = 0; m < 4; ++m) { const int row = row0 + ai * HALF + m * 16; const float rs = rsv[ai * 4 + m]; bf16* rowp = O + (size_t)row * ldc + col0;
#pragma unroll
                for (int bj = 0; bj < 2; ++bj) { const f32x4 v0 = acc[ai][bj][m][0] * rs, v1 = acc[ai][bj][m][1] * rs;
                    u32x4 w; w.x = cvt_pk_bf16(v0[0], v0[1]); w.y = cvt_pk_bf16(v0[2], v0[3]); w.z = cvt_pk_bf16(v1[0], v1[1]); w.w = cvt_pk_bf16(v1[2], v1[3]);
                    if (NT) __builtin_nontemporal_store(w, (u32x4*)(rowp + bj * HALF)); else *(u32x4*)(rowp + bj * HALF) = w; } }
    }
};
struct EpiSwiglu {
    static constexpr bool PERM = true; static constexpr int NSUB = 1;
    __device__ __forceinline__ int nstores(const Unit&) const { return 8; }
    bf16* O; int ldc; const float* ssq; const LAS float* tab = nullptr; int tab_pm = -1;
    __device__ __forceinline__ void operator()(f32x4 (&acc)[2][2][4][2], const Unit& u, int wr, int wc, int fr, int fq) const {
        asm volatile("" : "+v"(fr), "+v"(fq));
        const int row0 = u.pm * BM + wr * 64 + fr, col0 = u.pn * HALF + wc * 32 + 8 * fq;
        float rsv[8]; rstd8(ssq, tab, tab_pm, u, wr, fr, fq, rsv);
#pragma unroll
        for (int ai = 0; ai < 2; ++ai)
#pragma unroll
            for (int m = 0; m < 4; ++m) { const int row = row0 + ai * HALF + m * 16; const float rs = rsv[ai * 4 + m]; float h[8];
#pragma unroll
                for (int n = 0; n < 2; ++n) { const f32x4 g = acc[ai][0][m][n] * rs, up = acc[ai][1][m][n] * rs;
#pragma unroll
                    for (int j = 0; j < 4; ++j) h[n * 4 + j] = g[j] * up[j] * fast_rcp(1.0f + fast_exp(-g[j])); }
                u32x4 w; w.x = cvt_pk_bf16(h[0], h[1]); w.y = cvt_pk_bf16(h[2], h[3]); w.z = cvt_pk_bf16(h[4], h[5]); w.w = cvt_pk_bf16(h[6], h[7]);
                *(u32x4*)(O + ktm_off(M, row, col0)) = w; }
    }
};
struct EpiResid {
    static constexpr bool PERM = false; static constexpr int NSUB = 1;
    __device__ __forceinline__ int nstores(const Unit&) const { return 0; }
    bf16* xb; float* ssq; float scale; float* xout;
    __device__ __forceinline__ void operator()(f32x4 (&acc)[2][2][4][2], const Unit& u, int wr, int wc, int fr, int fq) const {
        asm volatile("" : "+v"(fr), "+v"(fq));
        const int row0 = u.pm * BM + wr * 64 + fr, col0 = u.pn * BM + wc * 32 + 4 * fq, colw = u.pn * BM + wc * 32 + (fq & 1) * 16 + (fq & 2) * 4;
        u32x4 xold[3][2];
#define RESID_LOAD(g) do { const int nr_ = row0 + ((g) >> 2) * HALF + ((g) & 3) * 16; _Pragma("unroll") for (int q = 0; q < 2; ++q) xold[(g) % 3][q] = *(const u32x4*)(xb + ktm_off(M, nr_, colw + q * HALF)); } while (0)
        RESID_LOAD(0); RESID_LOAD(1);
#pragma unroll
        for (int gi = 0; gi < 8; ++gi) { const int ai = gi >> 2, m = gi & 3; const int row = row0 + ai * HALF + m * 16; float ss = 0.f;
            if (gi + 2 < 8) RESID_LOAD(gi + 2);
#pragma unroll
            for (int bj = 0; bj < 2; ++bj) { const u32x4 W = xold[gi % 3][bj];
                const auto lx = __builtin_amdgcn_permlane16_swap(W.x, W.z, false, false); const auto ly = __builtin_amdgcn_permlane16_swap(W.y, W.w, false, false);
                unsigned px[2], py[2];
#pragma unroll
                for (int n = 0; n < 2; ++n) { const unsigned wx = lx[n], wy = ly[n];
                    const f32x4 xo = (f32x4){__uint_as_float(wx << 16), __uint_as_float(wx & 0xffff0000u), __uint_as_float(wy << 16), __uint_as_float(wy & 0xffff0000u)};
                    const f32x4 xn = xo + acc[ai][bj][m][n] * scale;
                    if (xout) *(f32x4*)(xout + (size_t)row * D + col0 + bj * HALF + n * 16) = xn;
                    ss += (xn[0] * xn[0] + xn[1] * xn[1]) + (xn[2] * xn[2] + xn[3] * xn[3]);
                    px[n] = cvt_pk_bf16(xn[0], xn[1]); py[n] = cvt_pk_bf16(xn[2], xn[3]); }
                const auto sx = __builtin_amdgcn_permlane16_swap(px[0], px[1], false, false); const auto sy = __builtin_amdgcn_permlane16_swap(py[0], py[1], false, false);
                *(u32x4*)(xb + ktm_off(M, row, colw + bj * HALF)) = (u32x4){sx[0], sy[0], sx[1], sy[1]}; }
            ss += __shfl_xor(ss, 16); ss += __shfl_xor(ss, 32);
            if (fq == 0) ssq[(size_t)row * 32 + u.pn * 4 + wc] = ss;
            asm volatile("" ::: "memory"); }
#undef RESID_LOAD
    }
};
struct EpiBranch {
    static constexpr bool PERM = true; static constexpr int NSUB = 3;
    __device__ __forceinline__ int nstores(const Unit&) const { return 0; }
    bf16* O; const bf16* GF;
    __device__ __forceinline__ static void up8(const u32x4& w, float (&f)[8]) { f[0] = bflo(w.x); f[1] = bfhi(w.x); f[2] = bflo(w.y); f[3] = bfhi(w.y); f[4] = bflo(w.z); f[5] = bfhi(w.z); f[6] = bflo(w.w); f[7] = bfhi(w.w); }
    __device__ __forceinline__ void operator()(f32x4 (&acc)[2][2][4][2], const Unit& u, int wr, int wc, int fr, int fq) const {
        asm volatile("" : "+v"(fr), "+v"(fq));
        const int s = u.sub; const int wid = wr * 4 + wc, lane = fq * 16 + fr;
        const bf16* ga = GF + gf_off(u.pm, s, u.pn, wid, 0, lane); const bf16* gb = GF + gf_off(u.pm, s < 2 ? s + 1 : s, u.pn, wid, 0, lane);
#pragma unroll
        for (int hb = 0; hb < 2; ++hb) {
            u32x4 wa[8], wb[8];
#pragma unroll
            for (int k = 0; k < 8; ++k) { wa[k] = *(const u32x4*)(ga + (size_t)((hb * 8 + k) * 64) * 8); if (s < 2) wb[k] = *(const u32x4*)(gb + (size_t)((hb * 8 + k) * 64) * 8); }
#pragma unroll
            for (int k = 0; k < 8; ++k) { const int k16 = hb * 8 + k, ai = k16 >> 3, m = (k16 >> 1) & 3, bj = k16 & 1; float f[8], fa[8]; up8(wa[k], fa);
                if (s < 2) { float fb[8]; up8(wb[k], fb);
#pragma unroll
                    for (int j = 0; j < 8; ++j) f[j] = fa[j] * fast_rcp(fb[j]); }
                else {
#pragma unroll
                    for (int j = 0; j < 8; ++j) f[j] = fa[j]; }
#pragma unroll
                for (int n = 0; n < 2; ++n)
#pragma unroll
                    for (int j = 0; j < 4; ++j) acc[ai][bj][m][n][j] *= f[n * 4 + j];
                if (s == 2) { const int row = u.pm * BM + wr * 64 + fr + ai * HALF + m * 16, col = u.pn * BM + wc * 32 + 8 * fq + bj * HALF; const f32x4 v0 = acc[ai][bj][m][0], v1 = acc[ai][bj][m][1];
                    u32x4 w; w.x = cvt_pk_bf16(v0[0], v0[1]); w.y = cvt_pk_bf16(v0[2], v0[3]); w.z = cvt_pk_bf16(v1[0], v1[1]); w.w = cvt_pk_bf16(v1[2], v1[3]);
                    *(u32x4*)(O + ktm_off(M, row, col)) = w; } } }
    }
};

__device__ __forceinline__ void fill_rstd_table(LAS float* tab, const float* ssq, int pm) {
    int t = threadIdx.x; asm volatile("" : "+v"(t));
    const float* p = ssq + ((size_t)pm * BM + (t >> 1)) * 32 + (t & 1) * 16;
    const f32x4 a = *(const f32x4*)p, b = *(const f32x4*)(p + 4), c = *(const f32x4*)(p + 8), d = *(const f32x4*)(p + 12);
    float sum = (((a[0] + a[1]) + (a[2] + a[3])) + ((b[0] + b[1]) + (b[2] + b[3]))) + (((c[0] + c[1]) + (c[2] + c[3])) + ((d[0] + d[1]) + (d[2] + d[3])));
    sum += __shfl_xor(sum, 1);
    if ((t & 1) == 0) tab[t >> 1] = rsqrtf(sum * (1.0f / D) + EPS);
    __syncthreads();
}
template <class Epi, class Sched, bool ALIGN_EPI>
__device__ __forceinline__ void gemm_phase(LAS unsigned char* lds, const Gemm g, const Sched& S, const Epi& E) {
    int tid = threadIdx.x; asm volatile("" : "+v"(tid));
    const int wid = __builtin_amdgcn_readfirstlane(tid >> 6), lane = tid & 63, wr = wid >> 2, wc = wid & 3, fr = lane & 15, fq = lane >> 4;
    const int nt = g.nt;
    unsigned voffA[2], voffB[2];
#pragma unroll
    for (int i = 0; i < 2; ++i) { voffA[i] = (unsigned)(tid * 16 + i * 8192); voffB[i] = voffA[i]; }
    const size_t kstepA = (size_t)g.ra * 128, kstepB = (size_t)g.rb * 128;
    constexpr size_t hstepA = (size_t)HALF * 128, hstepB = hstepA, tstepA = 2 * hstepA, tstepB = tstepA;
    const size_t sstepA = (size_t)g.nt * kstepA, sstepB = (size_t)g.nt * kstepB;
    const unsigned ldsw = (unsigned)wid * 1024u;
    const int aoff = lds_byte(wr * 64 + fr, fq * 8), boff = lds_byte(wc * 32 + fr, fq * 8);
#define PG8_SA(b, h) (((b) * 2 + (h)) * HTB)
#define PG8_SB(b, h) ((4 + (b) * 2 + (h)) * HTB)
#define PG8_STAGE(bufoff, gbase, voff) do { _Pragma("unroll") for (int _i = 0; _i < 2; ++_i) \
        __builtin_amdgcn_global_load_lds((const unsigned*)((const char*)(gbase) + (voff)[_i]), (LAS unsigned*)(lds + (bufoff) + ldsw + _i * 8192), 16, 0, 0); } while (0)
#define PG8_LDA(dst, b, h) do { _Pragma("unroll") for (int m = 0; m < 4; ++m) _Pragma("unroll") for (int k = 0; k < 2; ++k) dst[m][k] = *(const LAS bf16x8*)(lds + PG8_SA(b, h) + aoff + m * 2048 + k * 1024); } while (0)
#define PG8_LDB(dst, b, h) do { _Pragma("unroll") for (int n = 0; n < 2; ++n) _Pragma("unroll") for (int k = 0; k < 2; ++k) dst[n][k] = *(const LAS bf16x8*)(lds + PG8_SB(b, h) + boff + n * 2048 + k * 1024); } while (0)
#define PG8_MMA(ai, bj, At, Bt) do { __builtin_amdgcn_s_setprio(1); _Pragma("unroll") for (int m = 0; m < 4; ++m) _Pragma("unroll") for (int n = 0; n < 2; ++n) _Pragma("unroll") for (int k = 0; k < 2; ++k) \
        acc[ai][bj][m][n] = __builtin_amdgcn_mfma_f32_16x16x32_bf16(Bt[n][k], At[m][k], acc[ai][bj][m][n], 0, 0, 0); __builtin_amdgcn_s_setprio(0); } while (0)
#define PG8_WAIT_V(n) asm volatile("s_waitcnt vmcnt(" #n ")" ::: "memory")
#define PG8_WAIT_L(n) asm volatile("s_waitcnt lgkmcnt(" #n ")" ::: "memory")
#define PG8_BAR __builtin_amdgcn_s_barrier()
#define PG8_SCHED __builtin_amdgcn_sched_barrier(0)
    Unit cur, nxt; int ui = 0; int rs = 0;
    if (!S.next(0, cur)) return;
    f32x4 acc[2][2][4][2];
#pragma unroll
    for (int a = 0; a < 2; ++a)
#pragma unroll
        for (int b = 0; b < 2; ++b)
#pragma unroll
            for (int m = 0; m < 4; ++m)
#pragma unroll
                for (int n = 0; n < 2; ++n) acc[a][b][m][n] = (f32x4){0.f, 0.f, 0.f, 0.f};
    bf16x8 At[4][2], B0[2][2], B1[2][2];
    const char* cA = (const char*)g.A + (size_t)cur.pm * tstepA + (size_t)cur.sub * sstepA; const char* cB = (const char*)g.Bt + (size_t)cur.pn * tstepB + (size_t)cur.sub * sstepB;
    PG8_STAGE(PG8_SB(0, 0), cB, voffB); PG8_STAGE(PG8_SB(0, 1), cB + hstepB, voffB); PG8_STAGE(PG8_SA(0, 0), cA, voffA); PG8_STAGE(PG8_SA(0, 1), cA + hstepA, voffA);
    if (wr == 1) PG8_BAR;
    PG8_WAIT_V(2); PG8_BAR;
    PG8_STAGE(PG8_SB(1, 0), cB + kstepB, voffB); PG8_STAGE(PG8_SA(1, 0), cA + kstepA, voffA); PG8_STAGE(PG8_SB(1, 1), cB + hstepB + kstepB, voffB);
    PG8_WAIT_V(6); PG8_BAR;
    for (;;) {
        const bool has_next = S.next(ui + 1, nxt);
        const char* nA = has_next ? (const char*)g.A + (size_t)nxt.pm * tstepA + (size_t)nxt.sub * sstepA : cA; const char* nB = has_next ? (const char*)g.Bt + (size_t)nxt.pn * tstepB + (size_t)nxt.sub * sstepB : cB;
#define PG8_ITER(t, W1, W2, W3) do { \
            const bool last = ((t) == nt - 2); \
            const char* a1 = cA + (size_t)((t) + 1) * kstepA; \
            const char* a2 = last ? nA : cA + (size_t)((t) + 2) * kstepA; const char* b2 = last ? nB : cB + (size_t)((t) + 2) * kstepB; \
            const char* a3 = a2 + kstepA; const char* b3 = b2 + kstepB; \
              \
            PG8_LDB(B0, 0, 0); PG8_LDB(B1, 0, 1); PG8_SCHED; PG8_LDA(At, 0, 0); PG8_STAGE(PG8_SA(1, 1), a1 + hstepA, voffA); \
            PG8_WAIT_V(W1); PG8_WAIT_L(0); PG8_BAR; PG8_MMA(0, 0, At, B0); PG8_MMA(0, 1, At, B1); PG8_BAR; PG8_SCHED; \
              \
            PG8_LDA(At, 0, 1); PG8_STAGE(PG8_SB(0, 0), b2, voffB); PG8_STAGE(PG8_SB(0, 1), b2 + hstepB, voffB); PG8_STAGE(PG8_SA(0, 0), a2, voffA); \
            PG8_WAIT_V(W2); PG8_WAIT_L(0); PG8_BAR; PG8_MMA(1, 0, At, B0); PG8_MMA(1, 1, At, B1); PG8_BAR; PG8_SCHED; \
              \
            PG8_LDB(B0, 1, 0); PG8_LDB(B1, 1, 1); PG8_SCHED; PG8_LDA(At, 1, 0); PG8_STAGE(PG8_SA(0, 1), a2 + hstepA, voffA); \
            PG8_WAIT_V(W3); PG8_WAIT_L(0); PG8_BAR; PG8_MMA(0, 0, At, B0); PG8_MMA(0, 1, At, B1); PG8_BAR; PG8_SCHED; \
              \
            PG8_LDA(At, 1, 1); PG8_STAGE(PG8_SB(1, 0), b3, voffB); PG8_STAGE(PG8_SB(1, 1), b3 + hstepB, voffB); PG8_STAGE(PG8_SA(1, 0), a3, voffA); \
            PG8_WAIT_V(8); PG8_WAIT_L(0); PG8_BAR; PG8_MMA(1, 0, At, B0); PG8_MMA(1, 1, At, B1); PG8_BAR; PG8_SCHED; } while (0)
        int t0 = 0;
        if (rs) { PG8_ITER(0, 16, 16, 8); t0 = 2; }
        for (int t = t0; t < nt; t += 2) PG8_ITER(t, 8, 8, 8);
#undef PG8_ITER
        if constexpr (ALIGN_EPI) { if (wr == 0) PG8_BAR; }
        E(acc, cur, wr, wc, fr, fq);
        rs = E.nstores(cur);
        if (!has_next) break;
        if (cur.sub == Epi::NSUB - 1) {
#pragma unroll
            for (int a = 0; a < 2; ++a)
#pragma unroll
                for (int b = 0; b < 2; ++b)
#pragma unroll
                    for (int m = 0; m < 4; ++m)
#pragma unroll
                        for (int n = 0; n < 2; ++n) { acc[a][b][m][n] = (f32x4){0.f, 0.f, 0.f, 0.f}; asm volatile("" : "+v"(acc[a][b][m][n])); }
        }
        cur = nxt; cA = nA; cB = nB; ++ui;
        if constexpr (ALIGN_EPI) { if (wr == 1) PG8_BAR; }
    }
    PG8_WAIT_V(0);
    if constexpr (!ALIGN_EPI) { if (wr == 0) PG8_BAR; }
    PG8_BAR;
#undef PG8_SA
#undef PG8_SB
#undef PG8_STAGE
#undef PG8_LDA
#undef PG8_LDB
#undef PG8_MMA
#undef PG8_WAIT_V
#undef PG8_WAIT_L
#undef PG8_BAR
#undef PG8_SCHED
}
}

#define XB_TMO      128
#define XB_XCNT(j)  (256  + 64 * (j))
#define XB_XSUB(j)  (1280 + 64 * (j))
#define XB_XGEN(j)  (2304 + 64 * (j))
#define XB_TOP      3328
#define XB_TOPGEN   3392
#define XCD_BAR_WORDS 3456
#define XB_SPIN_CAP (1u << 18)
__device__ __forceinline__ unsigned xb_ld(unsigned* p)              { return __hip_atomic_load(p, __ATOMIC_RELAXED, __HIP_MEMORY_SCOPE_AGENT); }
__device__ __forceinline__ unsigned xb_add(unsigned* p, unsigned v) { return __hip_atomic_fetch_add(p, v, __ATOMIC_RELAXED, __HIP_MEMORY_SCOPE_AGENT); }
__device__ __forceinline__ unsigned xb_xcc_id() { return (unsigned)__builtin_amdgcn_s_getreg((3 << 11) | 20) & 0xFu; }
#define XB_SPIN(cond, bar) do { unsigned _sp = 0; while (cond) { __builtin_amdgcn_s_sleep(1); \
    if ((++_sp & 255u) == 0u) { if (xb_ld(&(bar)[XB_TMO])) break; if (_sp > XB_SPIN_CAP) { atomicAdd(&(bar)[XB_TMO], 1u); break; } } } } while (0)
struct XcdBarrier { unsigned* bar; unsigned x; volatile LAS unsigned* st; };
__device__ __forceinline__ XcdBarrier xcd_barrier_post(unsigned* bar, volatile LAS unsigned* st) {
    XcdBarrier b; b.bar = bar; b.x = xb_xcc_id(); b.st = st;
    if (threadIdx.x == 0) (void)xb_add(&bar[XB_XCNT(b.x)], 1u);
    return b;
}
__device__ __forceinline__ void xcd_barrier_complete(unsigned* bar, unsigned x, unsigned& nloc, unsigned& nx) {
    const unsigned G = gridDim.x * gridDim.y * gridDim.z;
    unsigned sum, cnt, mine, sp = 0u;
    for (;;) {
        sum = 0u; cnt = 0u; mine = 0u;
#pragma unroll
        for (unsigned j = 0; j < 16; ++j) { const unsigned c = xb_ld(&bar[XB_XCNT(j)]); sum += c; cnt += (c > 0u) ? 1u : 0u; mine = (j == x) ? c : mine; }
        if (sum == G) break;
        __builtin_amdgcn_s_sleep(1);
        if ((++sp & 255u) == 0u) { if (xb_ld(&bar[XB_TMO])) break; if (sp > XB_SPIN_CAP) { atomicAdd(&bar[XB_TMO], 1u); break; } }
    }
    nloc = mine > 0u ? mine : 1u; nx = cnt > 0u ? cnt : 1u;
}
__device__ __forceinline__ void xcd_barrier(const XcdBarrier& b) {
    asm volatile("s_waitcnt vmcnt(0)" ::: "memory");
    __syncthreads();
    if (threadIdx.x == 0) {
        unsigned* bar = b.bar;
        __builtin_amdgcn_s_waitcnt(0);
        unsigned nloc = b.st[0], nx = b.st[1];
        if (nloc == 0u) { xcd_barrier_complete(bar, b.x, nloc, nx); b.st[0] = nloc; b.st[1] = nx; }
        const unsigned old = xb_add(&bar[XB_XSUB(b.x)], 1u);
        const unsigned gen = old / nloc;
        if (old + 1u == (gen + 1u) * nloc) {
            __builtin_amdgcn_fence(__ATOMIC_RELEASE, "agent");
            asm volatile("s_waitcnt vmcnt(0)" ::: "memory");
            const unsigned og = xb_add(&bar[XB_TOP], 1u);
            const unsigned tg = og / nx;
            if (og + 1u == (tg + 1u) * nx) xb_add(&bar[XB_TOPGEN], 1u);
            else XB_SPIN(xb_ld(&bar[XB_TOPGEN]) == tg, bar);
            __builtin_amdgcn_fence(__ATOMIC_ACQUIRE, "agent");
            xb_add(&bar[XB_XGEN(b.x)], 1u);
            asm volatile("s_waitcnt vmcnt(0)" ::: "memory");
        } else {
            XB_SPIN(xb_ld(&bar[XB_XGEN(b.x)]) == gen, bar);
            __builtin_amdgcn_fence(__ATOMIC_ACQUIRE, "agent");
            asm volatile("s_waitcnt vmcnt(0)" ::: "memory");
        }
    }
    __syncthreads();
}


namespace pg8 {
struct EpiResidFin {
    static constexpr bool PERM = false; static constexpr int NSUB = 1;
    __device__ __forceinline__ int nstores(const Unit&) const { return 0; }
    const bf16* xb; float* out; float* ssq; float scale; const float* gain; unsigned* bar; unsigned* cnt;
    __device__ __forceinline__ void operator()(f32x4 (&acc)[2][2][4][2], const Unit& u, int wr, int wc, int fr, int fq) const {
        asm volatile("" : "+v"(fr), "+v"(fq));
        const int row0 = u.pm * BM + wr * 64 + fr, col0 = u.pn * BM + wc * 32 + 4 * fq, colw = u.pn * BM + wc * 32 + (fq & 1) * 16 + (fq & 2) * 4;
        u32x4 xold[3][2];
#define RESID_LOAD(g) do { const int nr_ = row0 + ((g) >> 2) * HALF + ((g) & 3) * 16; _Pragma("unroll") for (int q = 0; q < 2; ++q) xold[(g) % 3][q] = *(const u32x4*)(xb + ktm_off(M, nr_, colw + q * HALF)); } while (0)
        RESID_LOAD(0); RESID_LOAD(1);
#pragma unroll
        for (int gi = 0; gi < 8; ++gi) { const int ai = gi >> 2, m = gi & 3; const int row = row0 + ai * HALF + m * 16; float ss = 0.f;
            if (gi + 2 < 8) RESID_LOAD(gi + 2);
#pragma unroll
            for (int bj = 0; bj < 2; ++bj) { const u32x4 W = xold[gi % 3][bj];
                const auto lx = __builtin_amdgcn_permlane16_swap(W.x, W.z, false, false); const auto ly = __builtin_amdgcn_permlane16_swap(W.y, W.w, false, false);
#pragma unroll
                for (int n = 0; n < 2; ++n) { const unsigned wx = lx[n], wy = ly[n];
                    const f32x4 xo = (f32x4){__uint_as_float(wx << 16), __uint_as_float(wx & 0xffff0000u), __uint_as_float(wy << 16), __uint_as_float(wy & 0xffff0000u)};
                    const f32x4 xn = xo + acc[ai][bj][m][n] * scale; acc[ai][bj][m][n] = xn;
                    ss += (xn[0] * xn[0] + xn[1] * xn[1]) + (xn[2] * xn[2] + xn[3] * xn[3]); } }
            ss += __shfl_xor(ss, 16); ss += __shfl_xor(ss, 32);
            if (fq == 0) __hip_atomic_store((__attribute__((address_space(1))) float*)(ssq + (size_t)row * 32 + u.pn * 4 + wc), ss, __ATOMIC_RELAXED, __HIP_MEMORY_SCOPE_AGENT); }
#undef RESID_LOAD
        asm volatile("s_waitcnt vmcnt(0)" ::: "memory");
        __syncthreads();
        if (threadIdx.x == 0) {
            (void)xb_add(&cnt[u.pm * 16], 1u);
            XB_SPIN(xb_ld(&cnt[u.pm * 16]) < (unsigned)(D / BM), bar);
            __builtin_amdgcn_fence(__ATOMIC_ACQUIRE, "agent");
        }
        __syncthreads();
        f32x4 gn[4];
#pragma unroll
        for (int q = 0; q < 4; ++q) gn[q] = *(const f32x4*)(gain + col0 + (q >> 1) * HALF + (q & 1) * 16);
#pragma unroll
        for (int gi = 0; gi < 8; ++gi) { const int ai = gi >> 2, m = gi & 3; const int row = row0 + ai * HALF + m * 16;
            const f32x4 pa = *(const f32x4*)(ssq + (size_t)row * 32 + fq * 8), pb = *(const f32x4*)(ssq + (size_t)row * 32 + fq * 8 + 4);
            float t = ((pa[0] + pa[1]) + (pa[2] + pa[3])) + ((pb[0] + pb[1]) + (pb[2] + pb[3]));
            t += __shfl_xor(t, 16); t += __shfl_xor(t, 32);
            const float rs = rsqrtf(t * (1.0f / D) + EPS);
#pragma unroll
            for (int bj = 0; bj < 2; ++bj)
#pragma unroll
                for (int n = 0; n < 2; ++n) *(f32x4*)(out + (size_t)row * D + col0 + bj * HALF + n * 16) = acc[ai][bj][m][n] * rs * gn[bj * 2 + n]; }
    }
};
}

struct Args { const float* in[20]; float* out; unsigned char* ws; int ph_lo, ph_hi; };
struct Frame {
    LAS unsigned char* lds;
    int vcu, G;
    const float* const* in;
    float* out; unsigned char* ws;
};
#define IDS() int tid_ = threadIdx.x; asm volatile("" : "+v"(tid_)); const int TID = tid_, LANE = tid_ & 63, WAVE = __builtin_amdgcn_readfirstlane(tid_ >> 6)
__device__ __forceinline__ bf16* wl_ptr(unsigned char* ws, int l, size_t off) { return (bf16*)(ws + WS_WL + (size_t)l * WL_SIZE + off); }

template <bool GAIN>
__device__ __forceinline__ void tr_item(const float* W, int N, int k0, int n0, const float* gain, bf16* WT, size_t ldd, int drow0, int dk0, int lane, bool PERMB) {
    const int kc = lane & 7, nn = lane >> 3;
    const float* src = W + (size_t)(k0 + 8 * kc) * N + n0 + 4 * nn;
    f32x4 v[8];
#pragma unroll
    for (int j = 0; j < 8; ++j) v[j] = __builtin_nontemporal_load((const f32x4*)(src + (size_t)j * N));
    if (GAIN) { const f32x4 g0 = *(const f32x4*)(gain + k0 + 8 * kc), g1 = *(const f32x4*)(gain + k0 + 8 * kc + 4);
#pragma unroll
        for (int j = 0; j < 4; ++j) { v[j] = v[j] * g0[j]; v[4 + j] = v[4 + j] * g1[j]; } }
#pragma unroll
    for (int e = 0; e < 4; ++e) { u32x4 o; o.x = cvt_pk_bf16(v[0][e], v[1][e]); o.y = cvt_pk_bf16(v[2][e], v[3][e]); o.z = cvt_pk_bf16(v[4][e], v[5][e]); o.w = cvt_pk_bf16(v[6][e], v[7][e]);
        const int nrow = drow0 + 4 * nn + e;
        *(u32x4*)(WT + ktm_off((int)ldd, PERMB ? perm_slot(nrow) : nrow, dk0 + 8 * kc)) = o; }
}
__device__ __forceinline__ void p_prologue(Frame& F, int l_lo, int l_hi, bool misc) {
    IDS();
    const int gw = F.vcu * NWAVES + WAVE, NGW = F.G * NWAVES;
    constexpr int I_G = 32 * 176, I_D = 88 * 64, I_IN = 32 * 448, I_BR = 3 * 16 * 64, I_O = 32 * 64;
    constexpr int I_LAYER = 4 * I_G + 2 * I_D + I_IN + I_BR + I_O, I_KV = 32 * 64;
    const int nL = (l_hi - l_lo) * I_LAYER, nJ = nL + (misc ? DEPTH * I_KV : 0);
    for (int j = gw; j < nJ; j += NGW) {
        const int it = j < nL ? l_lo * I_LAYER + j : DEPTH * I_LAYER + (j - nL);
        const float* W; const float* gain = nullptr; bf16* WT; int N, k0, n0, drow0, dk0; size_t ldd; bool permb = true;
        if (it < DEPTH * I_LAYER) {
            const int l = it / I_LAYER; int r = it - l * I_LAYER;
            if (r < 2 * I_G || (r >= 2 * I_G + I_D + I_IN + I_BR + I_O && r < 4 * I_G + I_D + I_IN + I_BR + I_O)) {
                const bool second = r >= 2 * I_G; if (second) r -= 2 * I_G + I_D + I_IN + I_BR + I_O;
                const bool up = r >= I_G; if (up) r -= I_G;
                const int kb = r / 176, nb = r - kb * 176; N = FF; k0 = kb * 64; n0 = nb * 32;
                W = F.in[second ? (up ? 17 : 16) : (up ? 4 : 3)] + (size_t)l * D * FF; gain = F.in[second ? 15 : 2] + l * D;
                WT = wl_ptr(F.ws, l, second ? WL_GU2 : WL_GU1); ldd = 2 * FF; drow0 = (n0 >> 7) * 256 + (n0 & 127) + (up ? 128 : 0); dk0 = k0;
            } else if (r < 2 * I_G + I_D || r >= 4 * I_G + I_D + I_IN + I_BR + I_O) {
                const bool second = r >= 2 * I_G + I_D; r -= second ? (4 * I_G + I_D + I_IN + I_BR + I_O) : (2 * I_G);
                if (second && l >= 1 && LAZY_D2) continue;
                const int kb = r / 64, nb = r - kb * 64; N = D; k0 = kb * 64; n0 = nb * 32;
                W = F.in[second ? 18 : 5] + (size_t)l * FF * D; WT = wl_ptr(F.ws, l, second ? WL_D2 : WL_D1); ldd = D; drow0 = n0; dk0 = k0; permb = false;
            } else { r -= 2 * I_G + I_D;
                if (r < I_IN) { const int kb = r / 448, nb = r - kb * 448; N = INC; k0 = kb * 64; n0 = nb * 32;
                    W = F.in[7] + (size_t)l * D * INC; gain = F.in[6] + l * D; WT = wl_ptr(F.ws, l, WL_IN); ldd = INC; dk0 = k0;
                    drow0 = n0 < 1024 ? (n0 >> 7) * 256 + (n0 & 127) : n0 < 2048 ? n0 + 1024 : n0 < 3072 ? ((n0 - 2048) >> 7) * 256 + 128 + (n0 & 127) : n0; }
                else { r -= I_IN;
                    if (r < I_BR) { const int s = r / 1024, rr = r - s * 1024, kb = rr / 64, nb = rr - kb * 64; N = D; k0 = kb * 64; n0 = nb * 32;
                        W = F.in[13] + (size_t)(l * 3 + s) * NBW * D; WT = wl_ptr(F.ws, l, WL_BR); ldd = D; drow0 = n0; dk0 = s * NBW + k0; }
                    else { r -= I_BR; const int kb = r / 64, nb = r - kb * 64; N = D; k0 = kb * 64; n0 = nb * 32;
                        W = F.in[14] + (size_t)l * D * D; WT = wl_ptr(F.ws, l, WL_O); ldd = D; drow0 = n0; dk0 = k0; permb = false; } } }
        } else {
            int r = it - DEPTH * I_LAYER; const int l = r / I_KV; r -= l * I_KV; const int kb = r / 64, nb = r - kb * 64; N = D; k0 = kb * 64; n0 = nb * 32;
            W = F.in[12] + (size_t)l * D * D; gain = F.in[11] + l * D; ldd = 4096; dk0 = k0;
            if (n0 < 1024) { WT = (bf16*)(F.ws + WS_WK); drow0 = l * 1024 + n0; } else { WT = (bf16*)(F.ws + WS_WV); drow0 = l * 1024 + n0 - 1024; permb = false; }
        }
        if (gain) tr_item<true>(W, N, k0, n0, gain, WT, ldd, drow0, dk0, LANE, permb);
        else tr_item<false>(W, N, k0, n0, gain, WT, ldd, drow0, dk0, LANE, permb);
    }
    if (!misc) return;
    float* ssq0 = (float*)(F.ws + WS_SSQ);
    bf16* xb = (bf16*)(F.ws + WS_XB); bf16* memb = (bf16*)(F.ws + WS_MEMB);
    for (int row = gw; row < M + MEMR; row += NGW) {
        const bool isx = row < M; const float* src = isx ? F.in[0] + (size_t)row * D : F.in[1] + (size_t)(row - M) * D;
        f32x4 v[8]; float s = 0.f;
#pragma unroll
        for (int j = 0; j < 8; ++j) { v[j] = *(const f32x4*)(src + 4 * LANE + 256 * j); s += (v[j][0] * v[j][0] + v[j][1] * v[j][1]) + (v[j][2] * v[j][2] + v[j][3] * v[j][3]); }
        s = wave_sum(s);
        float rs = 1.0f; bf16* dst; int rr, RR;
        if (isx) { if (LANE < 32) ssq0[(size_t)row * 32 + LANE] = (LANE == 0) ? s : 0.f; dst = xb; rr = row; RR = M; } else { rs = rsqrtf(s * (1.0f / D) + EPS); dst = memb; rr = row - M; RR = MEMR; }
#pragma unroll
        for (int j = 0; j < 8; ++j) { u32x2 w; w.x = cvt_pk_bf16(v[j][0] * rs, v[j][1] * rs); w.y = cvt_pk_bf16(v[j][2] * rs, v[j][3] * rs); *(u32x2*)(dst + ktm_off(RR, rr, 4 * LANE + 256 * j)) = w;
            if (!isx) *(u32x2*)((bf16*)(F.ws + WS_MEMBP) + ktm_off(RR, perm_slot(rr), 4 * LANE + 256 * j)) = w; }
    }
    float* lbv = (float*)(F.ws + WS_LBV);
    for (int d = gw * 64 + LANE; d < 1024; d += NGW * 64) {
        const float a0 = F.in[9][d], a1 = F.in[9][1024 + d], a2 = F.in[9][2048 + d], a3 = F.in[9][3072 + d];
        const float mx = fmaxf(fmaxf(a0, a1), fmaxf(a2, a3));
        const float e0 = expf(a0 - mx), e1 = expf(a1 - mx), e2 = expf(a2 - mx), e3 = expf(a3 - mx), inv = 1.0f / (e0 + e1 + e2 + e3);
        lbv[d] = 0.f; lbv[1024 + d] = e1 * inv; lbv[2048 + d] = (e1 + e2) * inv; lbv[3072 + d] = (e1 + e2 + e3) * inv;
    }
}

__device__ __forceinline__ void p_convert_d2(Frame& F, int l, int hf) {
    IDS();
    const int cb = (int)blockIdx.x - F.G / 2; if (cb < 0) return;
    const int nw = (F.G - F.G / 2) * NWAVES; constexpr int I_D = 88 * 64;
    const float* W = F.in[18] + (size_t)l * FF * D; bf16* WT = wl_ptr(F.ws, l, WL_D2);
    for (int r = hf * (I_D / 2) + cb * NWAVES + WAVE; r < (hf + 1) * (I_D / 2); r += nw) { const int kb = r / 64, nb = r - kb * 64;
        tr_item<false>(W, D, kb * 64, nb * 32, nullptr, WT, D, nb * 32, kb * 64, LANE, false); }
}

constexpr int AT_STRIDE = 528;
__device__ __forceinline__ void p_attn(Frame& F, int l) {
    IDS();
    const bf16* P = (const bf16*)(F.ws + WS_P); const bf16* KB = (const bf16*)(F.ws + WS_KB); const bf16* VT = (const bf16*)(F.ws + WS_VT); bf16* YC = (bf16*)(F.ws + WS_YCAT);
    const int g = LANE >> 4, fr = LANE & 15;
    for (int unit = blockIdx.x; unit < BATCH * 4 * 16; unit += F.G) {
        const int b = unit >> 6, h = (unit >> 4) & 3, qb = unit & 15;
        const bf16* Kg = KB + (size_t)(b * MEML) * 4096 + l * 1024 + h * 256;
        const int srow = TID >> 5, sc16 = TID & 31;
        {   u32x4 kr[16];
#pragma unroll
            for (int i = 0; i < 16; ++i) kr[i] = *(const u32x4*)(Kg + (size_t)(srow + 16 * i) * 4096 + sc16 * 8);
#pragma unroll
            for (int i = 0; i < 16; ++i) *(LAS u32x4*)(F.lds + (srow + 16 * i) * AT_STRIDE + sc16 * 16) = kr[i]; }
        const bf16* Vg = VT + (size_t)(l * 1024 + h * 256) * 1024 + b * MEML;
        u32x4 vr[8];
#pragma unroll
        for (int i = 0; i < 8; ++i) vr[i] = *(const u32x4*)(Vg + (size_t)(srow + 16 * i) * 1024 + sc16 * 8);
        const int row = b * SEQ + qb * 128 + 16 * WAVE + fr;
        const bf16* Qg = P + (size_t)row * PST + C_AQ + h * 256 + g * 8;
        bf16x8 qf[8];
#pragma unroll
        for (int ks = 0; ks < 8; ++ks) qf[ks] = *(const bf16x8*)(Qg + ks * 32);
        __syncthreads();
        f32x4 s[16];
#pragma unroll
        for (int blk = 0; blk < 16; ++blk) { s[blk] = (f32x4){0.f, 0.f, 0.f, 0.f};
#pragma unroll
            for (int ks = 0; ks < 8; ++ks) { const bf16x8 a = *(const LAS bf16x8*)(F.lds + (16 * blk + fr) * AT_STRIDE + ks * 64 + g * 16); s[blk] = __builtin_amdgcn_mfma_f32_16x16x32_bf16(a, qf[ks], s[blk], 0, 0, 0); }
            if (blk & 1) asm volatile("" ::: "memory"); }
        u32x4 v2[8];
#pragma unroll
        for (int i = 0; i < 8; ++i) v2[i] = *(const u32x4*)(Vg + (size_t)(srow + 16 * (i + 8)) * 1024 + sc16 * 8);
        float mx = -3.0e38f;
#pragma unroll
        for (int blk = 0; blk < 16; ++blk) mx = fmaxf(mx, fmaxf(fmaxf(s[blk][0], s[blk][1]), fmaxf(s[blk][2], s[blk][3])));
        mx = fmaxf(mx, __shfl_xor(mx, 16)); mx = fmaxf(mx, __shfl_xor(mx, 32));
        float sum = 0.f;
#pragma unroll
        for (int blk = 0; blk < 16; ++blk)
#pragma unroll
            for (int r = 0; r < 4; ++r) { const float p = fast_exp((s[blk][r] - mx) * 0.0625f); s[blk][r] = p; sum += p; }
        sum += __shfl_xor(sum, 16); sum += __shfl_xor(sum, 32);
        bf16x8 pf[8];
#pragma unroll
        for (int i = 0; i < 8; ++i) { u32x4 w; w.x = cvt_pk_bf16(s[2 * i][0], s[2 * i][1]); w.y = cvt_pk_bf16(s[2 * i][2], s[2 * i][3]); w.z = cvt_pk_bf16(s[2 * i + 1][0], s[2 * i + 1][1]); w.w = cvt_pk_bf16(s[2 * i + 1][2], s[2 * i + 1][3]); pf[i] = __builtin_bit_cast(bf16x8, w); }
        __syncthreads();
        {
#pragma unroll
            for (int i = 0; i < 8; ++i) *(LAS u32x4*)(F.lds + (srow + 16 * i) * AT_STRIDE + sc16 * 16) = vr[i];
#pragma unroll
            for (int i = 0; i < 8; ++i) *(LAS u32x4*)(F.lds + (srow + 16 * (i + 8)) * AT_STRIDE + sc16 * 16) = v2[i]; }
        __syncthreads();
        const float inv = 1.0f / sum;
        const int ocol = 2 * NBW + h * 256 + 4 * g;
#pragma unroll
        for (int db = 0; db < 16; ++db) { f32x4 o = (f32x4){0.f, 0.f, 0.f, 0.f};
#pragma unroll
            for (int i = 0; i < 8; ++i) { const LAS unsigned char* vp = F.lds + (16 * db + fr) * AT_STRIDE + (32 * i + 4 * g) * 2;
                const u32x2 lo = *(const LAS u32x2*)vp, hi = *(const LAS u32x2*)(vp + 32); u32x4 w; w.x = lo.x; w.y = lo.y; w.z = hi.x; w.w = hi.y;
                o = __builtin_amdgcn_mfma_f32_16x16x32_bf16(__builtin_bit_cast(bf16x8, w), pf[i], o, 0, 0, 0); }
            u32x2 w; w.x = cvt_pk_bf16(o[0] * inv, o[1] * inv); w.y = cvt_pk_bf16(o[2] * inv, o[3] * inv); *(u32x2*)(YC + ktm_off(M, row, ocol + 16 * db)) = w; }
        __syncthreads();
    }
}

__device__ __forceinline__ void ld8f(const bf16* p, float (&f)[8]) { const u32x4 w = *(const u32x4*)p; f[0] = bflo(w.x); f[1] = bfhi(w.x); f[2] = bflo(w.y); f[3] = bfhi(w.y); f[4] = bflo(w.z); f[5] = bfhi(w.z); f[6] = bflo(w.w); f[7] = bfhi(w.w); }
__device__ __forceinline__ void cv8f(const u32x4 w, float (&f)[8]) { f[0] = bflo(w.x); f[1] = bfhi(w.x); f[2] = bflo(w.y); f[3] = bfhi(w.y); f[4] = bflo(w.z); f[5] = bfhi(w.z); f[6] = bflo(w.w); f[7] = bfhi(w.w); }
__device__ __forceinline__ void p_conv(Frame& F, int l) {
    IDS();
    const bf16* P = (const bf16*)(F.ws + WS_P); bf16* YC = (bf16*)(F.ws + WS_YCAT); const float* cw = F.in[8] + (size_t)l * 3 * NBW;
    const int c8 = (TID & 127) * 8, stride = F.G * 512;
    f32x4 wt[3][2];
#pragma unroll
    for (int j = 0; j < 3; ++j) { wt[j][0] = *(const f32x4*)(cw + j * NBW + c8); wt[j][1] = *(const f32x4*)(cw + j * NBW + c8 + 4); }
    for (int idx0 = F.vcu * 512 + TID; idx0 < M * 128; idx0 += 4 * stride) {
        u32x4 pv[4][3], bw[4];
#pragma unroll
        for (int q = 0; q < 4; ++q) { const int idx = idx0 + q * stride; const int row = idx >> 7, t = row & (SEQ - 1);
            if (idx < M * 128) {
#pragma unroll
                for (int j = 0; j < 3; ++j) pv[q][j] = (t - 2 + j >= 0) ? *(const u32x4*)(P + (size_t)(row - 2 + j) * PST + C_CX + c8) : (u32x4){0u, 0u, 0u, 0u};
                bw[q] = *(const u32x4*)(P + (size_t)row * PST + C_CB + c8); } }
#pragma unroll
        for (int q = 0; q < 4; ++q) { const int idx = idx0 + q * stride; const int row = idx >> 7;
            if (idx < M * 128) { float acc[8];
#pragma unroll
                for (int e = 0; e < 8; ++e) acc[e] = 0.f;
#pragma unroll
                for (int j = 0; j < 3; ++j) { float xv[8]; cv8f(pv[q][j], xv);
#pragma unroll
                    for (int e = 0; e < 4; ++e) { acc[e] += wt[j][0][e] * xv[e]; acc[4 + e] += wt[j][1][e] * xv[4 + e]; } }
                float bv[8]; cv8f(bw[q], bv);
                u32x4 w; w.x = cvt_pk_bf16(bv[0] * acc[0], bv[1] * acc[1]); w.y = cvt_pk_bf16(bv[2] * acc[2], bv[3] * acc[3]); w.z = cvt_pk_bf16(bv[4] * acc[4], bv[5] * acc[5]); w.w = cvt_pk_bf16(bv[6] * acc[6], bv[7] * acc[7]);
                *(u32x4*)(YC + ktm_off(M, row, c8)) = w; } }
    }
}

constexpr int HA_BF = 0, HA_QM = 32768, HA_KM = HA_QM + 64 * 272, HA_KET = HA_KM + 64 * 272, HA_VT = HA_KET + 128 * 144, HA_SEG = HA_VT + 128 * 144, HA_SLR = HA_SEG + 2048, HA_BPV = HA_SLR + 128 * 272, HA_END = HA_BPV + 512;
static_assert(HA_END <= MISC_OFF, "hgrn LDS");
constexpr int HG = 4, NGRP_H = NUNIT_H / HG;
__device__ __forceinline__ void p_hgrn_a(Frame& F, int l) {
    IDS();
    const bf16* P = (const bf16*)(F.ws + WS_P); const float* lbv = (const float*)(F.ws + WS_LBV) + l * 1024;
    bf16* UT = (bf16*)(F.ws + WS_UT); bf16* QB = (bf16*)(F.ws + WS_QB); bf16* OI = (bf16*)(F.ws + WS_OI); float* AV = (float*)(F.ws + WS_AV);
    LAS float* SEG = (LAS float*)(F.lds + HA_SEG); LAS float* BPV = (LAS float*)(F.lds + HA_BPV);
    const int g = LANE >> 4, fr = LANE & 15;
    for (int gi = blockIdx.x; gi < NGRP_H; gi += F.G) {
        const int b = gi >> 6, cg = (gi >> 3) & 7, h = gi & 7, bh = b * 8 + h, grp = bh * 8 + cg;
        const int t = (TID & 15) + 16 * (TID >> 7), d0 = ((TID >> 4) & 7) * 16;
        f32x4 SLv[8];
#pragma unroll
        for (int vb = 0; vb < 8; ++vb) SLv[vb] = (f32x4){0.f, 0.f, 0.f, 0.f};
        if (TID < 128) BPV[TID] = 0.f;
        u32x4 zr[2], qr[2], vr[2];
#define HA_FETCH(jc_) do { const bf16* pf_ = P + (size_t)(b * SEQ + (cg * HG + (jc_)) * 64 + t) * PST + h * 128 + d0; \
            zr[0] = *(const u32x4*)(pf_ + C_HF); zr[1] = *(const u32x4*)(pf_ + C_HF + 8); qr[0] = *(const u32x4*)(pf_ + C_HQ); qr[1] = *(const u32x4*)(pf_ + C_HQ + 8); \
            vr[0] = *(const u32x4*)(pf_ + C_HI); vr[1] = *(const u32x4*)(pf_ + C_HI + 8); } while (0)
        HA_FETCH(0);
        for (int jc = 0; jc < HG; ++jc) {
        const int c = cg * HG + jc, u = bh * 32 + c;
        float q[16], kk[16], bc[16];
        {   float z[16]; cv8f(zr[0], *(float(*)[8])&z[0]); cv8f(zr[1], *(float(*)[8])&z[8]); cv8f(qr[0], *(float(*)[8])&q[0]); cv8f(qr[1], *(float(*)[8])&q[8]);
#pragma unroll
            for (int i = 0; i < 16; i += 4) { const f32x4 lb4 = *(const f32x4*)(lbv + h * 128 + d0 + i);
#pragma unroll
                for (int j = 0; j < 4; ++j) { const float zz = fminf(fmaxf(z[i + j], -80.f), 80.f), e = fast_exp(-zz), sg = fast_rcp(1.0f + e), lb = lb4[j];
                    const float f = lb + (1.0f - lb) * sg; kk[i + j] = (1.0f - lb) * e * sg; bc[i + j] = __builtin_amdgcn_logf(fmaxf(f, 1e-30f)) * 0.69314718056f; } } }
        const int seg = TID >> 7;
#pragma unroll
        for (int i = 0; i < 16; ++i) { float v = bc[i];
            v += __int_as_float(__builtin_amdgcn_update_dpp(0, __float_as_int(v), 0x111, 0xf, 0xf, true));
            v += __int_as_float(__builtin_amdgcn_update_dpp(0, __float_as_int(v), 0x112, 0xf, 0xf, true));
            v += __int_as_float(__builtin_amdgcn_update_dpp(0, __float_as_int(v), 0x114, 0xf, 0xf, true));
            v += __int_as_float(__builtin_amdgcn_update_dpp(0, __float_as_int(v), 0x118, 0xf, 0xf, true));
            bc[i] = v; }
        if ((TID & 15) == 15) {
#pragma unroll
            for (int i = 0; i < 16; i += 4) *(LAS f32x4*)(SEG + seg * 128 + d0 + i) = (f32x4){bc[i], bc[i + 1], bc[i + 2], bc[i + 3]}; }
        __syncthreads();
        {   float vv[16]; cv8f(vr[0], *(float(*)[8])&vv[0]); cv8f(vr[1], *(float(*)[8])&vv[8]);
            unsigned qm[8], km[8], qb[8];
#pragma unroll
            for (int i = 0; i < 16; i += 4) { const f32x4 s0 = *(const LAS f32x4*)(SEG + d0 + i), s1 = *(const LAS f32x4*)(SEG + 128 + d0 + i), s2 = *(const LAS f32x4*)(SEG + 256 + d0 + i), s3 = *(const LAS f32x4*)(SEG + 384 + d0 + i);
                const f32x4 r4 = s0 + s1, l4 = r4 + (s2 + s3), zero4 = (f32x4){0.f, 0.f, 0.f, 0.f}, off4 = seg == 0 ? zero4 : seg == 1 ? s0 : seg == 2 ? r4 : r4 + s2;
                const f32x4 b4 = (f32x4){bc[i], bc[i + 1], bc[i + 2], bc[i + 3]} + off4, bp4 = *(const LAS f32x4*)(BPV + d0 + i);
                float qmv[4], kmv[4], qbv[4];
#pragma unroll
                for (int j = 0; j < 4; ++j) { const float bb = b4[j], rr = r4[j]; qmv[j] = q[i + j] * fast_exp(fminf(bb - rr, 80.f)); kmv[j] = kk[i + j] * fast_exp(fminf(rr - bb, 80.f)); qbv[j] = q[i + j] * fast_exp(bb + bp4[j]);
                    const float ke = kk[i + j] * fast_exp(l4[j] - bb);
                    *(LAS bf16*)(F.lds + HA_KET + (d0 + i + j) * 144 + t * 2) = (bf16)(cvt_pk_bf16(ke, 0.f) & 0xffffu);
                    *(LAS bf16*)(F.lds + HA_VT + (d0 + i + j) * 144 + t * 2) = (bf16)(cvt_pk_bf16(vv[i + j], 0.f) & 0xffffu); }
                qm[i / 2] = cvt_pk_bf16(qmv[0], qmv[1]); qm[i / 2 + 1] = cvt_pk_bf16(qmv[2], qmv[3]); km[i / 2] = cvt_pk_bf16(kmv[0], kmv[1]); km[i / 2 + 1] = cvt_pk_bf16(kmv[2], kmv[3]);
                qb[i / 2] = cvt_pk_bf16(qbv[0], qbv[1]); qb[i / 2 + 1] = cvt_pk_bf16(qbv[2], qbv[3]); }
            *(LAS u32x4*)(F.lds + HA_QM + t * 272 + d0 * 2) = (u32x4){qm[0], qm[1], qm[2], qm[3]}; *(LAS u32x4*)(F.lds + HA_QM + t * 272 + d0 * 2 + 16) = (u32x4){qm[4], qm[5], qm[6], qm[7]};
            *(LAS u32x4*)(F.lds + HA_KM + t * 272 + d0 * 2) = (u32x4){km[0], km[1], km[2], km[3]}; *(LAS u32x4*)(F.lds + HA_KM + t * 272 + d0 * 2 + 16) = (u32x4){km[4], km[5], km[6], km[7]};
            bf16* qg = QB + ((size_t)u * 64 + t) * 128 + d0;
            *(u32x4*)qg = (u32x4){qb[0], qb[1], qb[2], qb[3]}; *(u32x4*)(qg + 8) = (u32x4){qb[4], qb[5], qb[6], qb[7]};
            if (jc > 0) {
                const f32x4 rw = *(const LAS f32x4*)(SEG + 16 * WAVE + 4 * g) + *(const LAS f32x4*)(SEG + 128 + 16 * WAVE + 4 * g); const f32x4 er = (f32x4){fast_exp(rw[0]), fast_exp(rw[1]), fast_exp(rw[2]), fast_exp(rw[3])};
#pragma unroll
                for (int vb = 0; vb < 8; ++vb) { const f32x4 sv = SLv[vb] * er; u32x2 w; w.x = cvt_pk_bf16(sv[0], sv[1]); w.y = cvt_pk_bf16(sv[2], sv[3]);
                    *(LAS u32x2*)(F.lds + HA_SLR + (16 * vb + fr) * 272 + (16 * WAVE + 4 * g) * 2) = w; } }
        }
        __syncthreads();
        if (TID < 128) BPV[TID] += (SEG[TID] + SEG[128 + TID]) + (SEG[256 + TID] + SEG[384 + TID]);
        if (jc + 1 < HG) HA_FETCH(jc + 1);
        {   bf16x8 ka[2];
#pragma unroll
            for (int i = 0; i < 2; ++i) ka[i] = *(const LAS bf16x8*)(F.lds + HA_KET + (16 * WAVE + fr) * 144 + (32 * i + 8 * g) * 2);
            const f32x4 lw = (*(const LAS f32x4*)(SEG + 16 * WAVE + 4 * g) + *(const LAS f32x4*)(SEG + 128 + 16 * WAVE + 4 * g)) + (*(const LAS f32x4*)(SEG + 256 + 16 * WAVE + 4 * g) + *(const LAS f32x4*)(SEG + 384 + 16 * WAVE + 4 * g)); const f32x4 a4 = (f32x4){fast_exp(lw[0]), fast_exp(lw[1]), fast_exp(lw[2]), fast_exp(lw[3])};
#pragma unroll
            for (int vb = 0; vb < 8; ++vb) { f32x4 o = (f32x4){0.f, 0.f, 0.f, 0.f};
#pragma unroll
                for (int i = 0; i < 2; ++i) { const bf16x8 vbq = *(const LAS bf16x8*)(F.lds + HA_VT + (16 * vb + fr) * 144 + (32 * i + 8 * g) * 2); o = __builtin_amdgcn_mfma_f32_16x16x32_bf16(ka[i], vbq, o, 0, 0, 0); }
                SLv[vb] = a4 * SLv[vb] + o; } }
        {   const int tb = WAVE & 3, vh = WAVE >> 2;
            bf16x8 qfr[4];
#pragma unroll
            for (int i = 0; i < 4; ++i) qfr[i] = *(const LAS bf16x8*)(F.lds + HA_QM + (16 * tb + fr) * 272 + (32 * i + 8 * g) * 2);
            f32x4 sc[4];
#pragma unroll
            for (int sb = 0; sb < 4; ++sb) { sc[sb] = (f32x4){0.f, 0.f, 0.f, 0.f};
                if (sb <= tb) {
#pragma unroll
                    for (int i = 0; i < 4; ++i) { const bf16x8 ka = *(const LAS bf16x8*)(F.lds + HA_KM + (16 * sb + fr) * 272 + (32 * i + 8 * g) * 2); sc[sb] = __builtin_amdgcn_mfma_f32_16x16x32_bf16(ka, qfr[i], sc[sb], 0, 0, 0); }
                    if (sb == tb) {
#pragma unroll
                        for (int r = 0; r < 4; ++r) if (4 * g + r > fr) sc[sb][r] = 0.f; } } }
            bf16x8 pf[2];
#pragma unroll
            for (int i = 0; i < 2; ++i) { u32x4 w; w.x = cvt_pk_bf16(sc[2 * i][0], sc[2 * i][1]); w.y = cvt_pk_bf16(sc[2 * i][2], sc[2 * i][3]); w.z = cvt_pk_bf16(sc[2 * i + 1][0], sc[2 * i + 1][1]); w.w = cvt_pk_bf16(sc[2 * i + 1][2], sc[2 * i + 1][3]); pf[i] = __builtin_bit_cast(bf16x8, w); }
#pragma unroll
            for (int vq = 0; vq < 4; ++vq) { const int vb = vh * 4 + vq; f32x4 o = (f32x4){0.f, 0.f, 0.f, 0.f};
#pragma unroll
                for (int i = 0; i < 2; ++i) { const LAS unsigned char* vp = F.lds + HA_VT + (16 * vb + fr) * 144 + (32 * i + 4 * g) * 2;
                    const u32x2 lo = *(const LAS u32x2*)vp, hi = *(const LAS u32x2*)(vp + 32); u32x4 w; w.x = lo.x; w.y = lo.y; w.z = hi.x; w.w = hi.y;
                    o = __builtin_amdgcn_mfma_f32_16x16x32_bf16(__builtin_bit_cast(bf16x8, w), pf[i], o, 0, 0, 0); }
                if (jc > 0) {
#pragma unroll
                    for (int i = 0; i < 4; ++i) { const bf16x8 sa = *(const LAS bf16x8*)(F.lds + HA_SLR + (16 * vb + fr) * 272 + (32 * i + 8 * g) * 2); o = __builtin_amdgcn_mfma_f32_16x16x32_bf16(sa, qfr[i], o, 0, 0, 0); } }
                u32x2 w; w.x = cvt_pk_bf16(o[0], o[1]); w.y = cvt_pk_bf16(o[2], o[3]);
                *(u32x2*)(OI + ((size_t)u * 64 + 16 * tb + fr) * 128 + 16 * vb + 4 * g) = w; } }
        __syncthreads();
        }
#pragma unroll
        for (int vb = 0; vb < 8; ++vb) { u32x2 w; w.x = cvt_pk_bf16(SLv[vb][0], SLv[vb][1]); w.y = cvt_pk_bf16(SLv[vb][2], SLv[vb][3]);
            *(u32x2*)(UT + ((size_t)grp * 128 + 16 * vb + fr) * 128 + 16 * WAVE + 4 * g) = w; }
        if (TID < 128) AV[(size_t)grp * 128 + TID] = fast_exp(BPV[TID]);
        __syncthreads();
#undef HA_FETCH
    }
}
constexpr int HC_AV_OFF = 40960;
constexpr int HC_STRIDE = 272;
__device__ __forceinline__ void p_hgrn_c(Frame& F, int l) {
    IDS();
    const bf16* P = (const bf16*)(F.ws + WS_P); const bf16* UT = (const bf16*)(F.ws + WS_UT); const float* AV = (const float*)(F.ws + WS_AV); const bf16* QB = (const bf16*)(F.ws + WS_QB); const bf16* OI = (const bf16*)(F.ws + WS_OI);
    bf16* YC = (bf16*)(F.ws + WS_YCAT); const float* ng = F.in[10] + l * 128;
    const int g = LANE >> 4, fr = LANE & 15;
    for (int gi = blockIdx.x; gi < NGRP_H; gi += F.G) {
        const int b = gi >> 6, cg = (gi >> 3) & 7, h = gi & 7, bh = b * 8 + h;
        {   const int v = TID >> 2, dq = (TID & 3) * 32;
            float st[32];
#pragma unroll
            for (int i = 0; i < 32; ++i) st[i] = 0.f;
            LAS float* AVL = (LAS float*)(F.lds + HC_AV_OFF);
            for (int idx = TID; idx < cg * 128; idx += NWAVES * 64) AVL[idx] = AV[(size_t)(bh * (32 / HG)) * 128 + idx];
            u32x4 uw[7][4];
#pragma unroll
            for (int j = 0; j < 7; ++j) if (j < cg) {
#pragma unroll
                for (int i = 0; i < 4; ++i) uw[j][i] = *(const u32x4*)(UT + ((size_t)(bh * (32 / HG) + j) * 128 + v) * 128 + dq + 8 * i); }
            __syncthreads();
#pragma unroll
            for (int j = 0; j < 7; ++j) if (j < cg) { f32x4 aw[8];
#pragma unroll
                for (int i = 0; i < 8; ++i) aw[i] = *(const LAS f32x4*)(AVL + j * 128 + dq + 4 * i);
#pragma unroll
                for (int i = 0; i < 4; ++i) { const unsigned ww[4] = {uw[j][i].x, uw[j][i].y, uw[j][i].z, uw[j][i].w};
#pragma unroll
                    for (int k = 0; k < 4; ++k) { const int e = 8 * i + 2 * k; st[e] = aw[e >> 2][e & 3] * st[e] + bflo(ww[k]); st[e + 1] = aw[(e + 1) >> 2][(e + 1) & 3] * st[e + 1] + bfhi(ww[k]); } } }
#pragma unroll
            for (int i = 0; i < 4; ++i) { u32x4 w; w.x = cvt_pk_bf16(st[8 * i], st[8 * i + 1]); w.y = cvt_pk_bf16(st[8 * i + 2], st[8 * i + 3]); w.z = cvt_pk_bf16(st[8 * i + 4], st[8 * i + 5]); w.w = cvt_pk_bf16(st[8 * i + 6], st[8 * i + 7]);
                *(LAS u32x4*)(F.lds + v * HC_STRIDE + (dq + 8 * i) * 2) = w; } }
        __syncthreads();
#pragma unroll 1
        for (int r2 = 0; r2 < 2; ++r2) {
        const int tk = WAVE * 2 + r2, jc = tk >> 2, tb = tk & 3, c = cg * HG + jc, u = bh * 32 + c;
        f32x4 o[8];
#pragma unroll
        for (int vb = 0; vb < 8; ++vb) { const u32x2 w = *(const u32x2*)(OI + ((size_t)u * 64 + 16 * tb + fr) * 128 + 16 * vb + 4 * g); o[vb] = (f32x4){bflo(w.x), bfhi(w.x), bflo(w.y), bfhi(w.y)}; }
        bf16x8 bq[4];
#pragma unroll
        for (int i = 0; i < 4; ++i) bq[i] = *(const bf16x8*)(QB + ((size_t)u * 64 + 16 * tb + fr) * 128 + 32 * i + 8 * g);
        if (cg > 0) {
#pragma unroll
            for (int i = 0; i < 4; ++i)
#pragma unroll
                for (int vb = 0; vb < 8; ++vb) { const bf16x8 a = *(const LAS bf16x8*)(F.lds + (16 * vb + fr) * HC_STRIDE + (32 * i + 8 * g) * 2); o[vb] = __builtin_amdgcn_mfma_f32_16x16x32_bf16(a, bq[i], o[vb], 0, 0, 0); } }
        float ss = 0.f;
#pragma unroll
        for (int vb = 0; vb < 8; ++vb) ss += (o[vb][0] * o[vb][0] + o[vb][1] * o[vb][1]) + (o[vb][2] * o[vb][2] + o[vb][3] * o[vb][3]);
        ss += __shfl_xor(ss, 16); ss += __shfl_xor(ss, 32);
        const float rs = rsqrtf(ss * (1.0f / 128.0f) + EPS);
        const int row = b * SEQ + c * 64 + 16 * tb + fr;
#pragma unroll
        for (int vb = 0; vb < 8; ++vb) { const int v0 = 16 * vb + 4 * g; const f32x4 n4 = *(const f32x4*)(ng + v0); const u32x2 gw2 = *(const u32x2*)(P + (size_t)row * PST + C_HG + h * 128 + v0);
            const float g0 = bflo(gw2.x), g1 = bfhi(gw2.x), g2 = bflo(gw2.y), g3 = bfhi(gw2.y);
            const float y0 = o[vb][0] * rs * n4[0] * g0 * fast_rcp(1.0f + fast_exp(-g0)), y1 = o[vb][1] * rs * n4[1] * g1 * fast_rcp(1.0f + fast_exp(-g1));
            const float y2 = o[vb][2] * rs * n4[2] * g2 * fast_rcp(1.0f + fast_exp(-g2)), y3 = o[vb][3] * rs * n4[3] * g3 * fast_rcp(1.0f + fast_exp(-g3));
            u32x2 w; w.x = cvt_pk_bf16(y0, y1); w.y = cvt_pk_bf16(y2, y3); *(u32x2*)(YC + ktm_off(M, row, NBW + h * 128 + v0)) = w; }
        }
        __syncthreads();
    }
}
__device__ __forceinline__ void p_final(Frame& F) {
    IDS();
    const int gw = F.vcu * NWAVES + WAVE, NGW = F.G * NWAVES; const float* fn = F.in[19];
    for (int row = gw; row < M; row += NGW) { float* xr = F.out + (size_t)row * D;
        f32x4 v[8]; float s = 0.f;
#pragma unroll
        for (int j = 0; j < 8; ++j) { v[j] = *(const f32x4*)(xr + 4 * LANE + 256 * j); s += (v[j][0] * v[j][0] + v[j][1] * v[j][1]) + (v[j][2] * v[j][2] + v[j][3] * v[j][3]); }
        s = wave_sum(s); const float rs = rsqrtf(s * (1.0f / D) + EPS);
#pragma unroll
        for (int j = 0; j < 8; ++j) { const f32x4 gn = *(const f32x4*)(fn + 4 * LANE + 256 * j); *(f32x4*)(xr + 4 * LANE + 256 * j) = v[j] * rs * gn; }
    }
}

constexpr int PH_PRO = 0, PH_L0 = 1, PH_FINAL = 37, NPH = 38;
__global__ void __launch_bounds__(NWAVES * 64, 2) fwd(Args args) {
    __shared__ __attribute__((aligned(16))) unsigned char lds_raw[LDS_BYTES];
    Frame F;
    F.lds = (LAS unsigned char*)lds_raw;
    F.G = gridDim.x; { const int bx = blockIdx.x; F.vcu = (F.G % 8 == 0) ? (bx % 8) * (F.G / 8) + bx / 8 : bx; }
    F.in = args.in; F.out = args.out; F.ws = args.ws;
    const int lo = args.ph_lo, hi = args.ph_hi;
    volatile LAS unsigned* MISC = (volatile LAS unsigned*)(F.lds + MISC_OFF);
    for (int u = threadIdx.x; u < 128; u += NWAVES * 64) MISC[u] = 0u;
    __syncthreads();
    XcdBarrier bar; bar.bar = (unsigned*)(F.ws + WS_CTL + CTL_BAR_OFF); bar.x = 0; bar.st = MISC + 8;
    if (hi - lo > 1) bar = xcd_barrier_post((unsigned*)(F.ws + WS_CTL + CTL_BAR_OFF), MISC + 8);
#define IN(k) (lo <= (k) && (k) < hi)
#define SEAM(k) do { if (IN(k) && IN((k) + 1)) xcd_barrier(bar); } while (0)
    float* ssq = (float*)(F.ws + WS_SSQ);
    const bool fuse_final = !MK_PER_PHASE && F.G == (M / 256) * (D / 256);
    bf16* XB = (bf16*)(F.ws + WS_XB); bf16* HMID = (bf16*)(F.ws + WS_HMID); bf16* PB = (bf16*)(F.ws + WS_P); bf16* YC = (bf16*)(F.ws + WS_YCAT); bf16* MG = (bf16*)(F.ws + WS_MERGED);

    if (IN(PH_PRO)) { p_prologue(F, 0, DEPTH, true); }
    SEAM(PH_PRO);
    int ph = PH_L0;
    for (int sl = 0; sl < 3 * DEPTH; ++sl) {
        const int l = sl / 3, kind = sl - 3 * l;
        if (kind != 1) {
            const bool second = kind == 2;
            if (IN(ph)) {
                pg8::Gemm g{XB, wl_ptr(F.ws, l, second ? WL_GU2 : WL_GU1), M, 2 * FF, D / 64}; pg8::TileOrder<1> S; S.init(M, 2 * FF, F.G, (int)blockIdx.x);
                pg8::EpiSwiglu E{HMID, FF, ssq + (size_t)sl * M * 32};
                { pg8::Unit u0; if (S.next(0, u0)) { pg8::fill_rstd_table((LAS float*)(F.lds + pg8::RSTD_LDS_OFF), E.ssq, u0.pm); E.tab = (const LAS float*)(F.lds + pg8::RSTD_LDS_OFF); E.tab_pm = u0.pm; } }
                pg8::gemm_phase<pg8::EpiSwiglu, pg8::TileOrder<1>, true>(F.lds, g, S, E);
                if (sl == 0) {
                    const int cb = (int)blockIdx.x - (int)(F.G / 2), Gh = F.G - F.G / 2, ck = cb >= 0 ? cb : (1 << 20), cv = cb >= 0 ? (cb + Gh / 2) % Gh : (1 << 20);
                    {   pg8::Gemm g2{(const bf16*)(F.ws + WS_MEMB), (const bf16*)(F.ws + WS_WK), MEMR, 4096, D / 64}; pg8::TileOrder<1> S2; S2.init(MEMR, 4096, Gh, ck);
                        pg8::EpiBf16Rs E2{(bf16*)(F.ws + WS_KB), 4096, nullptr, nullptr, 1 << 30};
                        pg8::gemm_phase<pg8::EpiBf16Rs, pg8::TileOrder<1>, true>(F.lds, g2, S2, E2); }
                    {   pg8::Gemm g2{(const bf16*)(F.ws + WS_WV), (const bf16*)(F.ws + WS_MEMBP), 4096, MEMR, D / 64}; pg8::TileOrder<1> S2; S2.init(4096, MEMR, Gh, cv);
                        pg8::EpiBf16Rs E2{(bf16*)(F.ws + WS_VT), MEMR, nullptr, nullptr, 1 << 30};
                        pg8::gemm_phase<pg8::EpiBf16Rs, pg8::TileOrder<1>, true>(F.lds, g2, S2, E2); } }
                if (LAZY_D2) { if (second && l + 1 < DEPTH) p_convert_d2(F, l + 1, 0); if (!second && l >= 1) p_convert_d2(F, l, 1); } }
            SEAM(ph);
            if (IN(ph + 1)) {
                pg8::Gemm g{HMID, wl_ptr(F.ws, l, second ? WL_D2 : WL_D1), M, D, FF / 64}; pg8::TileOrder<1> S; S.init(M, D, F.G, (int)blockIdx.x);
                if (sl == 3 * DEPTH - 1 && fuse_final) {
                    pg8::EpiResidFin E{XB, F.out, ssq + (size_t)(sl + 1) * M * 32, 0.5f, F.in[19], (unsigned*)(F.ws + WS_CTL + CTL_BAR_OFF), (unsigned*)(F.ws + WS_CTL + CTL_PANEL_OFF)};
                    pg8::gemm_phase<pg8::EpiResidFin, pg8::TileOrder<1>, true>(F.lds, g, S, E);
                } else {
                    pg8::EpiResid E{XB, ssq + (size_t)(sl + 1) * M * 32, 0.5f, (sl == 3 * DEPTH - 1) ? F.out : nullptr};
                    pg8::gemm_phase<pg8::EpiResid, pg8::TileOrder<1>, false>(F.lds, g, S, E); } }
            if (!(sl == 3 * DEPTH - 1 && fuse_final)) SEAM(ph + 1);
            ph += 2;
        } else {
            if (IN(ph)) {
                pg8::Gemm g{XB, wl_ptr(F.ws, l, WL_IN), M, INC, D / 64}; pg8::TileOrder<1> S; S.init(M, INC, F.G, (int)blockIdx.x);
                pg8::EpiBf16Rs E{PB, PST, ssq + (size_t)sl * M * 32, (bf16*)(F.ws + WS_GF), PST / 256};
                E.NT = true; E.prod_pn = 8;
                { pg8::Unit u0; if (S.next(0, u0)) { pg8::fill_rstd_table((LAS float*)(F.lds + pg8::RSTD_LDS_OFF), E.ssq, u0.pm); E.tab = (const LAS float*)(F.lds + pg8::RSTD_LDS_OFF); E.tab_pm = u0.pm; } }
                pg8::gemm_phase<pg8::EpiBf16Rs, pg8::TileOrder<1>, true>(F.lds, g, S, E); }
            SEAM(ph);
            if (IN(ph + 1)) {
                const bool cf = (blockIdx.x >> 3) & 1;
                if (cf) p_conv(F, l);
                if ((blockIdx.x >> 4) & 1) { p_attn(F, l); p_hgrn_a(F, l); } else { p_hgrn_a(F, l); p_attn(F, l); }
                if (!cf) p_conv(F, l); }
            SEAM(ph + 1);
            if (IN(ph + 2)) { p_hgrn_c(F, l); }
            SEAM(ph + 2);
            if (IN(ph + 3)) {
                pg8::Gemm g{YC, wl_ptr(F.ws, l, WL_BR), M, D, NBW / 64}; pg8::TileOrder<3> S; S.init(M, D, F.G, (int)blockIdx.x);
                pg8::EpiBranch E{MG, (const bf16*)(F.ws + WS_GF)};
                pg8::gemm_phase<pg8::EpiBranch, pg8::TileOrder<3>, false>(F.lds, g, S, E); }
            SEAM(ph + 3);
            if (IN(ph + 4)) {
                pg8::Gemm g{MG, wl_ptr(F.ws, l, WL_O), M, D, D / 64}; pg8::TileOrder<1> S; S.init(M, D, F.G, (int)blockIdx.x);
                pg8::EpiResid E{XB, ssq + (size_t)(sl + 1) * M * 32, 1.0f, nullptr};
                pg8::gemm_phase<pg8::EpiResid, pg8::TileOrder<1>, false>(F.lds, g, S, E); }
            SEAM(ph + 4);
            ph += 5;
        }
    }
    if (IN(PH_FINAL) && !fuse_final) { p_final(F); }
#undef IN
#undef SEAM
}

extern "C" void kernel_launch(void* const* d_in, const int* in_sizes, int n_in, void* d_out, int out_size, void* d_ws, size_t ws_size, hipStream_t stream) {
    static int grid = 0;
    if (grid == 0) {
        if (n_in != 20 || in_sizes[0] != M * D || out_size != M * D || ws_size < WS_END) { fprintf(stderr, "kernel_launch: unexpected shapes (n_in %d, in0 %d, out %d, ws %zu < %zu); nothing launched\n", n_in, n_in > 0 ? in_sizes[0] : -1, out_size, ws_size, (size_t)WS_END); grid = -1; return; }
        int dev = 0, cus = 0, per_cu = 0;
        if (hipGetDevice(&dev) != hipSuccess || hipDeviceGetAttribute(&cus, hipDeviceAttributeMultiprocessorCount, dev) != hipSuccess) { grid = -1; return; }
        if (hipOccupancyMaxActiveBlocksPerMultiprocessor(&per_cu, (const void*)fwd, NWAVES * 64, 0) != hipSuccess || per_cu < 1) fprintf(stderr, "kernel_launch: occupancy query reports %d\n", per_cu);
        (void)hipGetLastError();
        grid = cus;
    }
    if (grid < 0) return;
    if (hipMemsetAsync((char*)d_ws + WS_CTL, 0, CTL_ZERO_BYTES, stream) != hipSuccess) return;
    Args a{};
    for (int i = 0; i < 20; ++i) a.in[i] = (const float*)d_in[i];
    a.out = (float*)d_out; a.ws = (unsigned char*)d_ws;
#if MK_PER_PHASE
    for (int p = 0; p < NPH; ++p) { a.ph_lo = p; a.ph_hi = p + 1; hipLaunchKernelGGL(fwd, dim3(grid), dim3(NWAVES * 64), 0, stream, a); }
#else
    a.ph_lo = 0; a.ph_hi = NPH; hipLaunchKernelGGL(fwd, dim3(grid), dim3(NWAVES * 64), 0, stream, a);
#endif
}
```
